# Optimizing an MI355X kernel written in HIP

```python
import math
import jax, jax.numpy as jnp
from jax import lax
import numpy as np

D_MODEL = 2048
BATCH = 1
SEQ = 16384
DEPTH = 1

CHUNK = 64
EPS = 1e-6

S5_WIDTH = D_MODEL // 2
S5_GROUP = 16
S5_GROUPS = S5_WIDTH // S5_GROUP
S5_STATE = 64
S5_DT_MIN = 1e-3
S5_DT_MAX = 1e-1

RET_HEADS = 8
RET_WIDTH = D_MODEL // 2
RET_V_HEAD = RET_WIDTH // RET_HEADS
RET_QK_HEAD = RET_V_HEAD // 2
RET_QK = RET_HEADS * RET_QK_HEAD
ROPE_BASE = 10000.0

COL_SIZES = (S5_WIDTH, S5_WIDTH, RET_QK, RET_QK, RET_WIDTH, RET_WIDTH, D_MODEL, D_MODEL)
IN_COLS = 2 * S5_WIDTH + 2 * RET_QK + 2 * RET_WIDTH + 2 * D_MODEL
SPLIT_IDX = (S5_WIDTH,
             2 * S5_WIDTH,
             2 * S5_WIDTH + RET_QK,
             2 * S5_WIDTH + 2 * RET_QK,
             2 * S5_WIDTH + 2 * RET_QK + RET_WIDTH,
             2 * S5_WIDTH + 2 * RET_QK + 2 * RET_WIDTH,
             2 * S5_WIDTH + 2 * RET_QK + 2 * RET_WIDTH + D_MODEL)

kernel_name = "hybrid_s5_retention_gated_block"


def rms_norm(x, gain):
    xf = x.astype(jnp.float32)
    y = xf * lax.rsqrt(jnp.mean(xf * xf, axis=-1, keepdims=True) + EPS)
    return (y * gain.astype(jnp.float32)).astype(x.dtype)


def s5_mixer(u, lam_re, lam_im, log_step, b_re, b_im, c_re, c_im, d_skip, w_glu, b_glu):
    bsz, seq, _ = u.shape
    f32 = jnp.float32
    uf = u.astype(f32).reshape(bsz, seq, S5_GROUPS, S5_GROUP)
    lr = lam_re.astype(f32)
    li = lam_im.astype(f32)
    step = jnp.exp(log_step.astype(f32))[:, None]
    mag = jnp.exp(lr * step)
    ang = li * step
    ab_re = mag * jnp.cos(ang)
    ab_im = mag * jnp.sin(ang)
    den = lr * lr + li * li
    nr = ab_re - 1.0
    f_re = (nr * lr + ab_im * li) / den
    f_im = (ab_im * lr - nr * li) / den
    br = b_re.astype(f32)
    bi = b_im.astype(f32)
    bb_re = f_re[..., None] * br - f_im[..., None] * bi
    bb_im = f_re[..., None] * bi + f_im[..., None] * br
    bu_re = jnp.einsum('blgh,gph->blgp', uf, bb_re)
    bu_im = jnp.einsum('blgh,gph->blgp', uf, bb_im)
    a_re = jnp.broadcast_to(ab_re, bu_re.shape)
    a_im = jnp.broadcast_to(ab_im, bu_re.shape)

    def combine(e1, e2):
        a1r, a1i, b1r, b1i = e1
        a2r, a2i, b2r, b2i = e2
        return (a2r * a1r - a2i * a1i,
                a2r * a1i + a2i * a1r,
                a2r * b1r - a2i * b1i + b2r,
                a2r * b1i + a2i * b1r + b2i)

    _, _, xr, xi = lax.associative_scan(combine, (a_re, a_im, bu_re, bu_im), axis=1)
    y = (jnp.einsum('blgp,ghp->blgh', xr, c_re.astype(f32))
         - jnp.einsum('blgp,ghp->blgh', xi, c_im.astype(f32))
         + d_skip.astype(f32).reshape(S5_GROUPS, S5_GROUP) * uf)
    y = y.reshape(bsz, seq, S5_WIDTH)
    g = jax.nn.gelu(y)
    out = g * jax.nn.sigmoid(g @ w_glu.astype(f32) + b_glu.astype(f32))
    return out.astype(u.dtype)


def rotary(t, seq):
    d = t.shape[-1]
    inv = ROPE_BASE ** (-jnp.arange(0, d, 2, dtype=jnp.float32) / d)
    pos = jnp.arange(seq, dtype=jnp.float32)
    angle = pos[:, None] * inv[None, :]
    cos = jnp.cos(angle)[None, :, None, :]
    sin = jnp.sin(angle)[None, :, None, :]
    t1, t2 = t[..., : d // 2], t[..., d // 2:]
    return jnp.concatenate([t1 * cos - t2 * sin, t1 * sin + t2 * cos], axis=-1)


def retention(q, k, v):
    bsz, seq, _ = q.shape
    f32 = jnp.float32
    n = seq // CHUNK
    qh = rotary(q.astype(f32).reshape(bsz, seq, RET_HEADS, RET_QK_HEAD), seq)
    kh = rotary(k.astype(f32).reshape(bsz, seq, RET_HEADS, RET_QK_HEAD), seq) * (RET_QK_HEAD ** -0.5)
    vh = v.astype(f32).reshape(bsz, seq, RET_HEADS, RET_V_HEAD)
    qc = qh.reshape(bsz, n, CHUNK, RET_HEADS, RET_QK_HEAD)
    kc = kh.reshape(bsz, n, CHUNK, RET_HEADS, RET_QK_HEAD)
    vc = vh.reshape(bsz, n, CHUNK, RET_HEADS, RET_V_HEAD)
    log_g = jnp.log1p(-jnp.exp2(-5.0 - jnp.arange(RET_HEADS, dtype=f32)))
    idx = jnp.arange(CHUNK, dtype=f32)
    dmat = jnp.exp(jnp.abs(idx[:, None] - idx[None, :])[None] * log_g[:, None, None])
    scores = jnp.einsum('bnihd,bnjhd->bnhij', qc, kc) * dmat
    inner = jnp.einsum('bnhij,bnjhe->bnihe', scores, vc)
    zeta = jnp.exp((CHUNK - 1.0 - idx)[None, :] * log_g[:, None])
    kv = jnp.einsum('bnjhd,hj,bnjhe->bnhde', kc, zeta, vc)
    chunk_decay = jnp.exp(CHUNK * log_g)[None, :, None, None]

    def step(state, kv_i):
        return state * chunk_decay + kv_i, state

    init = jnp.zeros((bsz, RET_HEADS, RET_QK_HEAD, RET_V_HEAD), f32)
    _, prev = lax.scan(step, init, jnp.moveaxis(kv, 1, 0))
    prev = jnp.moveaxis(prev, 0, 1)
    xi = jnp.exp((idx + 1.0)[None, :] * log_g[:, None])
    cross = jnp.einsum('bnihd,bnhde,hi->bnihe', qc, prev, xi)
    o = (inner + cross).reshape(bsz, seq, RET_HEADS, RET_V_HEAD)
    o = o * lax.rsqrt(jnp.mean(o * o, axis=-1, keepdims=True) + EPS)
    return o.reshape(bsz, seq, RET_WIDTH).astype(q.dtype)


def setup_inputs(seed: int = 0) -> dict:
    key = jax.random.key(seed)
    ks = jax.random.split(key, 20)
    f32 = jnp.float32
    nrm = lambda k, s: jax.random.normal(k, s, f32)
    x = nrm(ks[0], (BATCH, SEQ, D_MODEL))
    norm_pre = 1.0 + 0.01 * nrm(ks[1], (DEPTH, D_MODEL))
    w_in = nrm(ks[2], (DEPTH, D_MODEL, IN_COLS)) * D_MODEL ** -0.5
    lam_re = -0.5 + 0.01 * nrm(ks[3], (DEPTH, S5_GROUPS, S5_STATE))
    lam_im = (math.pi * jnp.arange(S5_STATE, dtype=f32))[None, None, :] + 0.01 * nrm(ks[4], (DEPTH, S5_GROUPS, S5_STATE))
    log_step = jax.random.uniform(ks[5], (DEPTH, S5_GROUPS), f32, math.log(S5_DT_MIN), math.log(S5_DT_MAX))
    s5_b_re = nrm(ks[6], (DEPTH, S5_GROUPS, S5_STATE, S5_GROUP)) * (2 * S5_GROUP) ** -0.5
    s5_b_im = nrm(ks[7], (DEPTH, S5_GROUPS, S5_STATE, S5_GROUP)) * (2 * S5_GROUP) ** -0.5
    s5_c_re = nrm(ks[8], (DEPTH, S5_GROUPS, S5_GROUP, S5_STATE)) * (2 * S5_STATE) ** -0.5
    s5_c_im = nrm(ks[9], (DEPTH, S5_GROUPS, S5_GROUP, S5_STATE)) * (2 * S5_STATE) ** -0.5
    s5_d = nrm(ks[10], (DEPTH, S5_WIDTH))
    w_glu = nrm(ks[11], (DEPTH, S5_WIDTH, S5_WIDTH)) * S5_WIDTH ** -0.5
    b_glu = 0.01 * nrm(ks[12], (DEPTH, S5_WIDTH))
    w_proj_s5 = nrm(ks[13], (DEPTH, S5_WIDTH, D_MODEL)) * S5_WIDTH ** -0.5
    w_proj_ret = nrm(ks[14], (DEPTH, RET_WIDTH, D_MODEL)) * RET_WIDTH ** -0.5
    w_out = nrm(ks[15], (DEPTH, D_MODEL, D_MODEL)) * D_MODEL ** -0.5
    norm_post = 1.0 + 0.01 * nrm(ks[16], (DEPTH, D_MODEL))
    return {"x": x, "norm_pre": norm_pre, "w_in": w_in, "lam_re": lam_re, "lam_im": lam_im,
            "log_step": log_step, "s5_b_re": s5_b_re, "s5_b_im": s5_b_im, "s5_c_re": s5_c_re,
            "s5_c_im": s5_c_im, "s5_d": s5_d, "w_glu": w_glu, "b_glu": b_glu,
            "w_proj_s5": w_proj_s5, "w_proj_ret": w_proj_ret, "w_out": w_out, "norm_post": norm_post}


def reference(x, norm_pre, w_in, lam_re, lam_im, log_step, s5_b_re, s5_b_im, s5_c_re, s5_c_im,
              s5_d, w_glu, b_glu, w_proj_s5, w_proj_ret, w_out, norm_post):
    for l in range(DEPTH):
        h = rms_norm(x, norm_pre[l])
        proj = h @ w_in[l]
        u_s, z_s, q, k, v, z_r, gl_s, gl_r = jnp.split(proj, SPLIT_IDX, axis=-1)
        y_s = s5_mixer(u_s, lam_re[l], lam_im[l], log_step[l], s5_b_re[l], s5_b_im[l],
                       s5_c_re[l], s5_c_im[l], s5_d[l], w_glu[l], b_glu[l]) * jax.nn.silu(z_s)
        y_r = retention(q, k, v) * jax.nn.silu(z_r)
        m = (jax.nn.sigmoid(gl_s) * (y_s @ w_proj_s5[l])
             + jax.nn.sigmoid(gl_r) * (y_r @ w_proj_ret[l]))
        x = x + rms_norm(m @ w_out[l], norm_post[l])
    return x
```

```cpp
#include <hip/hip_runtime.h>
#include <hip/hip_cooperative_groups.h>
#include <cstdio>
#include <cstdint>
namespace cg = cooperative_groups;
namespace pg8 {
#define PG8_LAS __attribute__((address_space(3)))
typedef unsigned short bf16_t;
typedef short bf16x8 __attribute__((ext_vector_type(8)));
typedef float f32x4 __attribute__((ext_vector_type(4)));
typedef unsigned u32x4 __attribute__((ext_vector_type(4)));
constexpr int BM = 256, BK = 64, HALF = 128, HTB = HALF * BK * 2  , STAGE_BYTES = 8 * HTB, NXCD = 8, WGM = 8;

__host__ __device__ __forceinline__ int lds_byte(int r, int c) { const int st = (r >> 4) * 2 + (c >> 5), rr = r & 15, cc = c & 31, ob = rr * 64 + cc * 2; return st * 1024 + (ob ^ (((ob >> 9) & 1) << 5)); }
__host__ __device__ __forceinline__ void stage_rc(int b, int& R, int& C) { const int st = b / 1024, sb = b % 1024, swz = sb ^ (((sb >> 9) & 1) << 5); R = (st >> 1) * 16 + swz / 64; C = (st & 1) * 32 + (swz % 64) / 2; }
__host__ __device__ __forceinline__ int perm32(int rho) { const int n = rho >> 4, i = rho & 15; return 8 * (i >> 2) + 4 * n + (i & 3); }

struct Unit { int pm, pn; };
struct Gemm { const bf16_t* A; const bf16_t* Bt; int M, N, K; };

struct StaticOrder {
    int nM, nN, nwg, G, c;
    __host__ __device__ void init(int M, int N, int G_, int c_) { nM = M / BM; nN = N / BM; nwg = nM * nN; G = G_; c = c_; }
    __host__ __device__ bool next(int i, Unit& u) const {
        const long L = (long)i * G + c; if (L >= nwg) return false;
        int wgid = (int)L; { const int q = nwg / NXCD, r = nwg % NXCD, xcd = wgid % NXCD, off = wgid / NXCD; wgid = (xcd < r ? xcd * (q + 1) : r * (q + 1) + (xcd - r) * q) + off; }
        const int nig = WGM * nN, gid = wgid / nig, fm = gid * WGM, gsz = (nM - fm) < WGM ? (nM - fm) : WGM;
        u.pm = fm + ((wgid % nig) % gsz); u.pn = (wgid % nig) / gsz; return true;
    }
    __device__ __forceinline__ void a_ready(const Unit&) const {}
    __device__ __forceinline__ void done(const Unit&) const {}
};

__device__ __forceinline__ unsigned cvt_pk_bf16(float lo, float hi) { unsigned r; asm volatile("v_cvt_pk_bf16_f32 %0, %1, %2" : "=v"(r) : "v"(lo), "v"(hi)); return r; }
typedef float f32x2 __attribute__((ext_vector_type(2)));
__device__ __forceinline__ f32x2 gelu_pk(f32x2 v) {
    const f32x2 av = __builtin_elementwise_abs(v), d = av * 0.2316418882f + 1.0f;
    f32x2 t; t.x = __builtin_amdgcn_rcpf(d.x); t.y = __builtin_amdgcn_rcpf(d.y);
    f32x2 q = t * 0.5307027145f + (-0.7265760135f); q = q * t + 0.7107068705f; q = q * t + (-0.142248368f); q = q * t + 0.127414796f; q = q * t;
    const f32x2 s = (v * v) * (-0.72134752044f);
    f32x2 e; e.x = __builtin_amdgcn_exp2f(s.x); e.y = __builtin_amdgcn_exp2f(s.y);
    const f32x2 m = v * (q * e), r = v - m;
    f32x2 o; o.x = v.x < 0.f ? m.x : r.x; o.y = v.y < 0.f ? m.y : r.y; return o;
}

template <int ACT  > struct EpiBf16 {
    static constexpr bool PERM = true, AFTER_DRAIN = false; static_assert(ACT == 0 || ACT == 1, "EpiBf16: ACT is 0 (none) or 1 (gelu_pk)");
    bf16_t* O; int ldc; const float* bias; int split_cols; size_t split_stride; float scale0;
    __device__ __forceinline__ void operator()(const f32x4 (&acc)[2][2][4][2], const Unit& u, int wr, int wc, int fr, int fq) const {
        const int row0 = u.pm * BM + wr * 64 + fr; int colt = u.pn * BM; bf16_t* base = O;
        float sc = 1.f; if (split_cols) { const int t = colt / split_cols; base += (size_t)t * split_stride; colt -= t * split_cols; if (t == 0) sc = scale0; }
        const int col0 = colt + wc * 32 + 8 * fq, bcol0 = u.pn * BM + wc * 32 + 8 * fq;
        f32x4 bv[2][2];
#pragma unroll
        for (int bj = 0; bj < 2; ++bj)
#pragma unroll
            for (int n = 0; n < 2; ++n) bv[bj][n] = bias ? *(const f32x4*)(bias + bcol0 + bj * HALF + 4 * n) : (f32x4){0.f, 0.f, 0.f, 0.f};
#pragma unroll
        for (int ai = 0; ai < 2; ++ai)
#pragma unroll
            for (int m = 0; m < 4; ++m) { bf16_t* rowp = base + (size_t)(row0 + ai * HALF + m * 16) * ldc + col0;
#pragma unroll
                for (int bj = 0; bj < 2; ++bj) { f32x4 v0 = acc[ai][bj][m][0] + bv[bj][0], v1 = acc[ai][bj][m][1] + bv[bj][1];
                    if (ACT == 1) { f32x2 a = gelu_pk((f32x2){v0[0], v0[1]}), b = gelu_pk((f32x2){v0[2], v0[3]}), c = gelu_pk((f32x2){v1[0], v1[1]}), d = gelu_pk((f32x2){v1[2], v1[3]});
                        v0 = (f32x4){a.x, a.y, b.x, b.y}; v1 = (f32x4){c.x, c.y, d.x, d.y}; }
                    v0 = v0 * sc; v1 = v1 * sc; u32x4 w; w.x = cvt_pk_bf16(v0[0], v0[1]); w.y = cvt_pk_bf16(v0[2], v0[3]); w.z = cvt_pk_bf16(v1[0], v1[1]); w.w = cvt_pk_bf16(v1[2], v1[3]);
                    *(u32x4*)(rowp + bj * HALF) = w; } }
    }
};

template <class Epi, class Sched, bool ALIGN_EPI = false, bool SP2 = false>
__device__ __forceinline__ void gemm_phase(PG8_LAS unsigned char* lds, const Gemm g, const Sched& S, const Epi& E) {
    const int tid = threadIdx.x, wid = __builtin_amdgcn_readfirstlane(tid >> 6), lane = tid & 63, wr = wid >> 2, wc = wid & 3, fr = lane & 15, fq = lane >> 4;
    const int K = g.K, nt = K / BK;
    unsigned voffA[2], voffB[2];
#pragma unroll
    for (int i = 0; i < 2; ++i) { int R, C; stage_rc(tid * 16 + i * 8192, R, C); const int Rb = Epi::PERM ? ((R & ~31) + perm32(R & 31)) : R;
        voffA[i] = (unsigned)(R * K + C) * 2u; voffB[i] = (unsigned)(Rb * K + C) * 2u; }
    const size_t kstep = (size_t)(BK * 2);
    const size_t hstep = (size_t)HALF * K * 2;
    const size_t tstep = 2 * hstep;
    const unsigned ldsw = (unsigned)wid * 1024u;
    const int aoff = lds_byte(wr * 64 + fr, fq * 8), boff = lds_byte(wc * 32 + fr, fq * 8);
#define PG8_SA(b, h) (((b) * 2 + (h)) * HTB)
#define PG8_SB(b, h) ((4 + (b) * 2 + (h)) * HTB)
#define PG8_STAGE(bufoff, gbase, voff) do { _Pragma("unroll") for (int _i = 0; _i < 2; ++_i) \
        __builtin_amdgcn_global_load_lds((const unsigned*)((const char*)(gbase) + (voff)[_i]), (PG8_LAS unsigned*)(lds + (bufoff) + ldsw + _i * 8192), 16, 0, 0); } while (0)
#define PG8_LDA(dst, b, h) do { _Pragma("unroll") for (int m = 0; m < 4; ++m) _Pragma("unroll") for (int k = 0; k < 2; ++k) dst[m][k] = *(const PG8_LAS bf16x8*)(lds + PG8_SA(b, h) + aoff + m * 2048 + k * 1024); } while (0)
#define PG8_LDB(dst, b, h) do { _Pragma("unroll") for (int n = 0; n < 2; ++n) _Pragma("unroll") for (int k = 0; k < 2; ++k) dst[n][k] = *(const PG8_LAS bf16x8*)(lds + PG8_SB(b, h) + boff + n * 2048 + k * 1024); } while (0)
#define PG8_MMA(ai, bj, At, Bt) do { __builtin_amdgcn_s_setprio(1); _Pragma("unroll") for (int m = 0; m < 4; ++m) _Pragma("unroll") for (int n = 0; n < 2; ++n) _Pragma("unroll") for (int k = 0; k < 2; ++k) \
        acc[ai][bj][m][n] = __builtin_amdgcn_mfma_f32_16x16x32_bf16(Bt[n][k], At[m][k], acc[ai][bj][m][n], 0, 0, 0); __builtin_amdgcn_s_setprio(0); } while (0)
#define PG8_WAIT_V(n) asm volatile("s_waitcnt vmcnt(" #n ")" ::: "memory")
#define PG8_WAIT_L(n) asm volatile("s_waitcnt lgkmcnt(" #n ")" ::: "memory")
#define PG8_BAR __builtin_amdgcn_s_barrier()
#define PG8_SCHED __builtin_amdgcn_sched_barrier(0)
    Unit cur, nxt; int ui = 0;
    if (!S.next(0, cur)) return;
    f32x4 acc[2][2][4][2];
#pragma unroll
    for (int a = 0; a < 2; ++a)
#pragma unroll
        for (int b = 0; b < 2; ++b)
#pragma unroll
            for (int m = 0; m < 4; ++m)
#pragma unroll
                for (int n = 0; n < 2; ++n) acc[a][b][m][n] = (f32x4){0.f, 0.f, 0.f, 0.f};
    bf16x8 At[4][2], B0[2][2], B1[2][2];
    const char* cA = (const char*)g.A + (size_t)cur.pm * tstep; const char* cB = (const char*)g.Bt + (size_t)cur.pn * tstep;
    S.a_ready(cur);
    if constexpr (SP2) {
        PG8_STAGE(PG8_SB(0, 0), cB, voffB); PG8_STAGE(PG8_SB(0, 1), cB + hstep, voffB); PG8_STAGE(PG8_SA(0, 0), cA, voffA); PG8_STAGE(PG8_SA(0, 1), cA + hstep, voffA);
        if (wr == 1) PG8_BAR;
        PG8_WAIT_V(2); PG8_BAR;
        PG8_STAGE(PG8_SB(1, 0), cB + kstep, voffB); PG8_STAGE(PG8_SA(1, 0), cA + kstep, voffA); PG8_STAGE(PG8_SB(1, 1), cB + hstep + kstep, voffB);
        PG8_WAIT_V(6); PG8_BAR;
    } else {
        PG8_STAGE(PG8_SB(0, 0), cB, voffB); PG8_STAGE(PG8_SA(0, 0), cA, voffA); PG8_STAGE(PG8_SB(0, 1), cB + hstep, voffB); PG8_STAGE(PG8_SA(0, 1), cA + hstep, voffA);
        if (wr == 1) PG8_BAR;
        PG8_WAIT_V(4); PG8_BAR;
        PG8_STAGE(PG8_SB(1, 0), cB + kstep, voffB); PG8_STAGE(PG8_SA(1, 0), cA + kstep, voffA); PG8_STAGE(PG8_SB(1, 1), cB + hstep + kstep, voffB);
        PG8_WAIT_V(6); PG8_BAR;
    }
    for (;;) {
        const bool has_next = S.next(ui + 1, nxt);
        const char* nA = has_next ? (const char*)g.A + (size_t)nxt.pm * tstep : cA; const char* nB = has_next ? (const char*)g.Bt + (size_t)nxt.pn * tstep : cB;
        for (int t = 0; t < nt; t += 2) {
            const bool last = (t == nt - 2);
            const char* a1 = cA + (size_t)(t + 1) * kstep;
            const char* a2 = last ? nA : cA + (size_t)(t + 2) * kstep; const char* b2 = last ? nB : cB + (size_t)(t + 2) * kstep;
            const char* a3 = a2 + kstep; const char* b3 = b2 + kstep;
            if (last && has_next) S.a_ready(nxt);
            if constexpr (SP2) {
            PG8_LDB(B0, 0, 0); PG8_LDB(B1, 0, 1); PG8_SCHED; PG8_LDA(At, 0, 0); PG8_STAGE(PG8_SA(1, 1), a1 + hstep, voffA);
            PG8_WAIT_V(8); PG8_WAIT_L(0); PG8_BAR; PG8_MMA(0, 0, At, B0); PG8_MMA(0, 1, At, B1); PG8_BAR; PG8_SCHED;
            PG8_LDA(At, 0, 1); PG8_STAGE(PG8_SB(0, 0), b2, voffB); PG8_STAGE(PG8_SB(0, 1), b2 + hstep, voffB); PG8_STAGE(PG8_SA(0, 0), a2, voffA);
            PG8_WAIT_V(8); PG8_WAIT_L(0); PG8_BAR; PG8_MMA(1, 0, At, B0); PG8_MMA(1, 1, At, B1); PG8_BAR; PG8_SCHED;
            PG8_LDB(B0, 1, 0); PG8_LDB(B1, 1, 1); PG8_SCHED; PG8_LDA(At, 1, 0); PG8_STAGE(PG8_SA(0, 1), a2 + hstep, voffA);
            PG8_WAIT_V(8); PG8_WAIT_L(0); PG8_BAR; PG8_MMA(0, 0, At, B0); PG8_MMA(0, 1, At, B1); PG8_BAR; PG8_SCHED;
            PG8_LDA(At, 1, 1); PG8_STAGE(PG8_SB(1, 0), b3, voffB); PG8_STAGE(PG8_SB(1, 1), b3 + hstep, voffB); PG8_STAGE(PG8_SA(1, 0), a3, voffA);
            PG8_WAIT_V(8); PG8_WAIT_L(0); PG8_BAR; PG8_MMA(1, 0, At, B0); PG8_MMA(1, 1, At, B1); PG8_BAR; PG8_SCHED;
            } else {
            PG8_LDB(B0, 0, 0); PG8_SCHED; PG8_LDA(At, 0, 0); PG8_STAGE(PG8_SA(1, 1), a1 + hstep, voffA);
            PG8_WAIT_L(8); PG8_BAR; PG8_WAIT_L(0); PG8_MMA(0, 0, At, B0); PG8_BAR; PG8_SCHED;
            PG8_LDB(B1, 0, 1); PG8_STAGE(PG8_SB(0, 0), b2, voffB);
            PG8_BAR; PG8_WAIT_L(0); PG8_MMA(0, 1, At, B1); PG8_BAR;
            PG8_LDA(At, 0, 1); PG8_STAGE(PG8_SA(0, 0), a2, voffA);
            PG8_BAR; PG8_WAIT_L(0); PG8_MMA(1, 0, At, B0); PG8_BAR; PG8_SCHED;
            PG8_STAGE(PG8_SB(0, 1), b2 + hstep, voffB);
            PG8_WAIT_V(6); PG8_BAR; PG8_MMA(1, 1, At, B1); PG8_BAR;
            PG8_LDB(B0, 1, 0); PG8_SCHED; PG8_LDA(At, 1, 0); PG8_STAGE(PG8_SA(0, 1), a2 + hstep, voffA);
            PG8_WAIT_L(8); PG8_BAR; PG8_WAIT_L(0); PG8_MMA(0, 0, At, B0); PG8_BAR; PG8_SCHED;
            PG8_LDB(B1, 1, 1); PG8_STAGE(PG8_SB(1, 0), b3, voffB);
            PG8_BAR; PG8_WAIT_L(0); PG8_MMA(0, 1, At, B1); PG8_BAR;
            PG8_LDA(At, 1, 1); PG8_STAGE(PG8_SA(1, 0), a3, voffA);
            PG8_BAR; PG8_WAIT_L(0); PG8_MMA(1, 0, At, B0); PG8_BAR; PG8_SCHED;
            PG8_STAGE(PG8_SB(1, 1), b3 + hstep, voffB);
            PG8_WAIT_V(6); PG8_BAR; PG8_MMA(1, 1, At, B1); PG8_BAR;
            }
        }
        if constexpr (ALIGN_EPI) { if (wr == 0) PG8_BAR; }
        if constexpr (!Epi::AFTER_DRAIN) { E(acc, cur, wr, wc, fr, fq); S.done(cur); }
        if (!has_next) break;
#pragma unroll
        for (int a = 0; a < 2; ++a)
#pragma unroll
            for (int b = 0; b < 2; ++b)
#pragma unroll
                for (int m = 0; m < 4; ++m)
#pragma unroll
                    for (int n = 0; n < 2; ++n) acc[a][b][m][n] = (f32x4){0.f, 0.f, 0.f, 0.f};
        cur = nxt; cA = nA; cB = nB; ++ui;
        if constexpr (ALIGN_EPI) { if (wr == 1) PG8_BAR; }
    }
    PG8_WAIT_V(0);
    if constexpr (!ALIGN_EPI) { if (wr == 0) PG8_BAR; }
    PG8_BAR;
    if constexpr (Epi::AFTER_DRAIN) { E.fused(acc, cur, wr, wc, fr, fq, lds, wid, lane); S.done(cur); }
#undef PG8_SA
#undef PG8_SB
#undef PG8_STAGE
#undef PG8_LDA
#undef PG8_LDB
#undef PG8_MMA
#undef PG8_WAIT_V
#undef PG8_WAIT_L
#undef PG8_BAR
#undef PG8_SCHED
}
}

#define GAS __attribute__((address_space(1)))
#define LAS __attribute__((address_space(3)))
typedef unsigned short bf16;
typedef unsigned v4u __attribute__((ext_vector_type(4)));
typedef unsigned v2u __attribute__((ext_vector_type(2)));
typedef float f32x4 __attribute__((ext_vector_type(4)));
typedef float f32x2 __attribute__((ext_vector_type(2)));

constexpr int NWAVES = 8, NTHREADS = 512;
constexpr int M = 16384, D = 2048, NIN = 9216;
constexpr int S5W = 1024, S5G = 64, S5H = 16, S5P = 64;
constexpr int RH = 8, RDK = 64, RDV = 128, RQK = 512, RW = 1024, CH = 64, NCH = M / CH;
constexpr float EPS = 1e-6f;

constexpr size_t MiB = 1u << 20;
constexpr size_t WS_CTL = 0;
constexpr size_t WS_WIN = 1 * MiB;
constexpr size_t WS_WGLU = 37 * MiB;
constexpr size_t WS_WS = 39 * MiB;
constexpr size_t WS_WR = 43 * MiB;
constexpr size_t WS_WOUT = 47 * MiB;
constexpr size_t WS_ROT = 55 * MiB;
constexpr size_t WS_S5AB = 59 * MiB;
constexpr size_t WS_S5BB = 59 * MiB + 65536;
constexpr size_t WS_H = 64 * MiB;
constexpr size_t WS_G = 64 * MiB, WS_YR = 96 * MiB;
constexpr size_t WS_U = 128 * MiB;
constexpr size_t WS_YS = 128 * MiB;
constexpr size_t WS_ZS = 160 * MiB;
constexpr size_t WS_Q = 192 * MiB;
constexpr size_t WS_K = 208 * MiB;
constexpr size_t WS_V = 224 * MiB;
constexpr size_t WS_M1 = 192 * MiB;
constexpr size_t WS_ZR = 256 * MiB;
constexpr size_t WS_GS = 288 * MiB;
constexpr size_t WS_GR = 352 * MiB;
constexpr size_t WS_KV = 416 * MiB;
constexpr size_t WS_MM = 416 * MiB;
constexpr size_t WS_S5S = 480 * MiB;
constexpr size_t WS_T = 160 * MiB;
constexpr size_t WS_END = 488 * MiB;

constexpr int LDS_BYTES = 147456;

__device__ __forceinline__ unsigned f2bf(float f) { unsigned u = __builtin_bit_cast(unsigned, f); return (u + 0x7fffu + ((u >> 16) & 1u)) >> 16; }
__device__ __forceinline__ unsigned pk2(float lo, float hi) { return f2bf(lo) | (f2bf(hi) << 16); }
__device__ __forceinline__ float bf2f(unsigned short b) { return __builtin_bit_cast(float, ((unsigned)b) << 16); }
__device__ __forceinline__ float bflo(unsigned w) { return __builtin_bit_cast(float, w << 16); }
__device__ __forceinline__ float bfhi(unsigned w) { return __builtin_bit_cast(float, w & 0xffff0000u); }
__device__ __forceinline__ float sigmoidf_(float z) { return __builtin_amdgcn_rcpf(1.0f + __expf(-z)); }
__device__ __forceinline__ float siluf_(float z) { return z * sigmoidf_(z); }
__device__ __forceinline__ float gelu_tanh(float x) {
    const float t = 1.5957691216057308f * (x + 0.044715f * x * x * x);
    return x * sigmoidf_(t);
}
__device__ __forceinline__ float wave_sum(float v) {
#pragma unroll
    for (int o = 1; o < 64; o <<= 1) v += __shfl_xor(v, o);
    return v;
}

struct Frame {
    LAS unsigned char* lds;
    int tid, lane, wave, G, bid;
    const float* in[17];
    float* out;
    unsigned char* ws;
};

__device__ __forceinline__ void p0_transpose_item(const float* W, int K, int N, bf16* WT, int dest_row0, LAS float* scr, int k0, int n0, int lane) {
#pragma unroll 8
    for (int i = 0; i < 32; ++i) { const int kk = 2 * i + (lane >> 5); scr[kk * 33 + (lane & 31)] = W[(size_t)(k0 + kk) * N + n0 + (lane & 31)]; }
    asm volatile("s_waitcnt lgkmcnt(0)" ::: "memory");
    const int c = lane & 7;
#pragma unroll
    for (int j = 0; j < 4; ++j) { const int n = (lane >> 3) + 8 * j; const LAS float* s = scr + (8 * c) * 33 + n;
        v4u o; o.x = pk2(s[0 * 33], s[1 * 33]); o.y = pk2(s[2 * 33], s[3 * 33]); o.z = pk2(s[4 * 33], s[5 * 33]); o.w = pk2(s[6 * 33], s[7 * 33]);
        *(v4u*)(WT + (size_t)(dest_row0 + n) * K + k0 + 8 * c) = o; }
    asm volatile("s_waitcnt lgkmcnt(0)" ::: "memory");
}
__device__ __forceinline__ int win_dest_row(int n0) {
    if (n0 < 2048 || n0 >= 3072) return n0;
    const int w = n0 - 2048, T = w >> 8, r = w & 255, hh = r >> 6, s = (r >> 5) & 1;
    return 2048 + 256 * T + 128 * s + 32 * hh;
}
__device__ __forceinline__ void p0_prologue(Frame& F) {
    LAS float* scr = (LAS float*)(F.lds + F.wave * 16384);
    const int gw = F.bid * NWAVES + F.wave, NGW = F.G * NWAVES;
    bf16* WIN = (bf16*)(F.ws + WS_WIN); bf16* WGLU = (bf16*)(F.ws + WS_WGLU); bf16* WSs = (bf16*)(F.ws + WS_WS); bf16* WRr = (bf16*)(F.ws + WS_WR); bf16* WOUT = (bf16*)(F.ws + WS_WOUT);
    constexpr int I_IN = (D / 64) * (NIN / 32), I_GLU = (S5W / 64) * (S5W / 32), I_S = (S5W / 64) * (D / 32), I_R = (RW / 64) * (D / 32), I_OUT = (D / 64) * (D / 32);
    constexpr int NITEMS = I_IN + I_GLU + I_S + I_R + I_OUT;
    for (int it = gw; it < NITEMS; it += NGW) {
        int r = it;
        if (r < I_IN) { const int nb = NIN / 32, kb = r / nb, n0 = 32 * (r % nb); p0_transpose_item(F.in[2], D, NIN, WIN, win_dest_row(n0), scr, 64 * kb, n0, F.lane); continue; } r -= I_IN;
        if (r < I_GLU) { const int nb = S5W / 32, kb = r / nb, n0 = 32 * (r % nb); p0_transpose_item(F.in[11], S5W, S5W, WGLU, n0, scr, 64 * kb, n0, F.lane); continue; } r -= I_GLU;
        if (r < I_S) { const int nb = D / 32, kb = r / nb, n0 = 32 * (r % nb); p0_transpose_item(F.in[13], S5W, D, WSs, n0, scr, 64 * kb, n0, F.lane); continue; } r -= I_S;
        if (r < I_R) { const int nb = D / 32, kb = r / nb, n0 = 32 * (r % nb); p0_transpose_item(F.in[14], RW, D, WRr, n0, scr, 64 * kb, n0, F.lane); continue; } r -= I_R;
        { const int nb = D / 32, kb = r / nb, n0 = 32 * (r % nb); p0_transpose_item(F.in[15], D, D, WOUT, n0, scr, 64 * kb, n0, F.lane); }
    }
    {
        const float* x = F.in[0]; const float* gain = F.in[1]; bf16* H = (bf16*)(F.ws + WS_H);
        f32x4 gv[8];
#pragma unroll
        for (int j = 0; j < 8; ++j) gv[j] = *((const f32x4*)gain + F.lane + 64 * j);
        for (int m = gw; m < M; m += NGW) {
            const f32x4* xr = (const f32x4*)(x + (size_t)m * D) + F.lane;
            f32x4 v[8]; float s = 0.f;
#pragma unroll
            for (int j = 0; j < 8; ++j) { v[j] = xr[64 * j]; s += (v[j].x * v[j].x + v[j].y * v[j].y) + (v[j].z * v[j].z + v[j].w * v[j].w); }
            const float r = 1.0f / sqrtf(wave_sum(s) * (1.0f / D) + EPS);
            v2u* o8 = (v2u*)(H + (size_t)m * D) + F.lane;
#pragma unroll
            for (int j = 0; j < 8; ++j) { v2u w; w.x = pk2(v[j].x * r * gv[j].x, v[j].y * r * gv[j].y); w.y = pk2(v[j].z * r * gv[j].z, v[j].w * r * gv[j].w); o8[64 * j] = w; }
        }
    }
    {
        f32x2* rot = (f32x2*)(F.ws + WS_ROT);
        const int gt = F.bid * NTHREADS + F.tid, NGT = F.G * NTHREADS;
        for (int idx = gt; idx < M * 32; idx += NGT) {
            const int pos = idx >> 5, i = idx & 31;
            const float inv = exp2f(-(float)i * (13.287712379549449f / 32.0f));
            const float ang = (float)pos * inv;
            const double rev = (double)ang * 0.15915494309189535;
            const float fr = (float)(rev - __builtin_rint(rev));
            rot[idx] = (f32x2){__builtin_amdgcn_cosf(fr), __builtin_amdgcn_sinf(fr)};
        }
    }
    {
        const int gt = F.bid * NTHREADS + F.tid;
        if (gt < S5G * S5P) {
            const int g = gt >> 6;
            const float lr = F.in[3][gt], li = F.in[4][gt], step = __expf(F.in[5][g]);
            const float mag = __expf(lr * step), ang = li * step;
            const double rev = (double)ang * 0.15915494309189535;
            const float fr = (float)(rev - __builtin_rint(rev));
            const float abr = mag * __builtin_amdgcn_cosf(fr), abi = mag * __builtin_amdgcn_sinf(fr);
            const float den = lr * lr + li * li, nr = abr - 1.0f;
            const float fre = (nr * lr + abi * li) / den, fim = (abi * lr - nr * li) / den;
            f32x2* ab = (f32x2*)(F.ws + WS_S5AB);
            ab[gt] = (f32x2){abr, abi};
            float pr = abr, pi = abi;
#pragma unroll
            for (int q = 0; q < 6; ++q) { const float nr2 = pr * pr - pi * pi, ni2 = 2.0f * pr * pi; pr = nr2; pi = ni2; }
            ab[4096 + gt] = (f32x2){pr, pi};
            f32x2* bb = (f32x2*)(F.ws + WS_S5BB) + (size_t)gt * 16;
            const float* bre = F.in[6] + (size_t)gt * 16; const float* bim = F.in[7] + (size_t)gt * 16;
#pragma unroll
            for (int h = 0; h < 16; ++h) { const float br = bre[h], bi = bim[h]; bb[h] = (f32x2){fre * br - fim * bi, fre * bi + fim * br}; }
        }
    }
}

using pg8::Unit;
struct EpiIn {
    static constexpr bool PERM = true, AFTER_DRAIN = false;
    unsigned char* ws;
    __device__ __forceinline__ void operator()(const f32x4 (&acc)[2][2][4][2], const Unit& u, int wr, int wc, int fr, int fq) const {
        const int pn = u.pn, row0 = u.pm * 256 + wr * 64 + fr;
        if (pn >= 8 && pn < 12) {
            bf16* base = (bf16*)(ws + (pn < 10 ? WS_Q : WS_K)); const float sc = pn < 10 ? 1.0f : 0.125f;
            const int col0 = (pn & 1) * 256 + 64 * wc + 8 * fq;
            const f32x2* rot = (const f32x2*)(ws + WS_ROT);
#pragma unroll
            for (int ai = 0; ai < 2; ++ai)
#pragma unroll
                for (int m = 0; m < 4; ++m) {
                    const int row = row0 + ai * 128 + m * 16;
                    const f32x4* rp = (const f32x4*)(rot + (size_t)row * 32 + 8 * fq);
                    const f32x4 r0 = rp[0], r1 = rp[1], r2 = rp[2], r3 = rp[3];
                    const float cs[8] = {r0.x, r0.z, r1.x, r1.z, r2.x, r2.z, r3.x, r3.z};
                    const float sn[8] = {r0.y, r0.w, r1.y, r1.w, r2.y, r2.w, r3.y, r3.w};
                    float o1[8], o2[8];
#pragma unroll
                    for (int n = 0; n < 2; ++n)
#pragma unroll
                        for (int j = 0; j < 4; ++j) { const float t1 = acc[ai][0][m][n][j], t2 = acc[ai][1][m][n][j], c = cs[4 * n + j], s = sn[4 * n + j];
                            o1[4 * n + j] = (t1 * c - t2 * s) * sc; o2[4 * n + j] = (t1 * s + t2 * c) * sc; }
                    bf16* rowp = base + (size_t)row * RQK + col0;
                    v4u w1, w2;
                    w1.x = pk2(o1[0], o1[1]); w1.y = pk2(o1[2], o1[3]); w1.z = pk2(o1[4], o1[5]); w1.w = pk2(o1[6], o1[7]);
                    w2.x = pk2(o2[0], o2[1]); w2.y = pk2(o2[2], o2[3]); w2.z = pk2(o2[4], o2[5]); w2.w = pk2(o2[6], o2[7]);
                    *(v4u*)rowp = w1; *(v4u*)(rowp + 32) = w2;
                }
            return;
        }
        bf16* base; int ld, ct, act;
        if (pn < 4) { base = (bf16*)(ws + WS_U); ld = 1024; ct = pn; act = 0; }
        else if (pn < 8) { base = (bf16*)(ws + WS_ZS); ld = 1024; ct = pn - 4; act = 1; }
        else if (pn < 16) { base = (bf16*)(ws + WS_V); ld = 1024; ct = pn - 12; act = 0; }
        else if (pn < 20) { base = (bf16*)(ws + WS_ZR); ld = 1024; ct = pn - 16; act = 1; }
        else if (pn < 28) { base = (bf16*)(ws + WS_GS); ld = 2048; ct = pn - 20; act = 2; }
        else { base = (bf16*)(ws + WS_GR); ld = 2048; ct = pn - 28; act = 2; }
        const int col0 = ct * 256 + wc * 32 + 8 * fq;
#pragma unroll
        for (int ai = 0; ai < 2; ++ai)
#pragma unroll
            for (int m = 0; m < 4; ++m) { bf16* rowp = base + (size_t)(row0 + ai * 128 + m * 16) * ld + col0;
#pragma unroll
                for (int bj = 0; bj < 2; ++bj) { f32x4 v0 = acc[ai][bj][m][0], v1 = acc[ai][bj][m][1];
                    if (act == 1) {
#pragma unroll
                        for (int j = 0; j < 4; ++j) { v0[j] = siluf_(v0[j]); v1[j] = siluf_(v1[j]); } }
                    if (act == 2) {
#pragma unroll
                        for (int j = 0; j < 4; ++j) { v0[j] = sigmoidf_(v0[j]); v1[j] = sigmoidf_(v1[j]); } }
                    v4u w; w.x = pk2(v0[0], v0[1]); w.y = pk2(v0[2], v0[3]); w.z = pk2(v1[0], v1[1]); w.w = pk2(v1[2], v1[3]);
                    *(v4u*)(rowp + bj * 128) = w; } }
    }
};
struct EpiGlu {
    static constexpr bool PERM = true, AFTER_DRAIN = false;
    const bf16* G; const bf16* ZS; const float* bias; bf16* YS;
    __device__ __forceinline__ void operator()(const f32x4 (&acc)[2][2][4][2], const Unit& u, int wr, int wc, int fr, int fq) const {
        const int row0 = u.pm * 256 + wr * 64 + fr, col0 = u.pn * 256 + wc * 32 + 8 * fq;
#pragma unroll
        for (int ai = 0; ai < 2; ++ai)
#pragma unroll
            for (int m = 0; m < 4; ++m) { const size_t ro = (size_t)(row0 + ai * 128 + m * 16) * S5W + col0;
#pragma unroll
                for (int bj = 0; bj < 2; ++bj) {
                    const v4u gw = *(const v4u*)(G + ro + bj * 128), zw = *(const v4u*)(ZS + ro + bj * 128);
                    const f32x4 b0 = *(const f32x4*)(bias + col0 + bj * 128), b1 = *(const f32x4*)(bias + col0 + bj * 128 + 4);
                    const f32x4 v0 = acc[ai][bj][m][0] + b0, v1 = acc[ai][bj][m][1] + b1;
                    float o[8];
                    o[0] = bflo(gw.x) * sigmoidf_(v0[0]) * bflo(zw.x); o[1] = bfhi(gw.x) * sigmoidf_(v0[1]) * bfhi(zw.x);
                    o[2] = bflo(gw.y) * sigmoidf_(v0[2]) * bflo(zw.y); o[3] = bfhi(gw.y) * sigmoidf_(v0[3]) * bfhi(zw.y);
                    o[4] = bflo(gw.z) * sigmoidf_(v1[0]) * bflo(zw.z); o[5] = bfhi(gw.z) * sigmoidf_(v1[1]) * bfhi(zw.z);
                    o[6] = bflo(gw.w) * sigmoidf_(v1[2]) * bflo(zw.w); o[7] = bfhi(gw.w) * sigmoidf_(v1[3]) * bfhi(zw.w);
                    v4u w; w.x = pk2(o[0], o[1]); w.y = pk2(o[2], o[3]); w.z = pk2(o[4], o[5]); w.w = pk2(o[6], o[7]);
                    *(v4u*)(YS + ro + bj * 128) = w; } }
    }
};
template <bool ADD> struct EpiGate {
    static constexpr bool PERM = true, AFTER_DRAIN = false;
    const bf16* GATE; const bf16* PREV; bf16* O;
    __device__ __forceinline__ void operator()(const f32x4 (&acc)[2][2][4][2], const Unit& u, int wr, int wc, int fr, int fq) const {
        const int row0 = u.pm * 256 + wr * 64 + fr, col0 = u.pn * 256 + wc * 32 + 8 * fq;
#pragma unroll
        for (int ai = 0; ai < 2; ++ai)
#pragma unroll
            for (int m = 0; m < 4; ++m) { const size_t ro = (size_t)(row0 + ai * 128 + m * 16) * D + col0;
#pragma unroll
                for (int bj = 0; bj < 2; ++bj) {
                    const v4u gw = *(const v4u*)(GATE + ro + bj * 128);
                    const f32x4 v0 = acc[ai][bj][m][0], v1 = acc[ai][bj][m][1];
                    float o[8];
                    o[0] = bflo(gw.x) * v0[0]; o[1] = bfhi(gw.x) * v0[1]; o[2] = bflo(gw.y) * v0[2]; o[3] = bfhi(gw.y) * v0[3];
                    o[4] = bflo(gw.z) * v1[0]; o[5] = bfhi(gw.z) * v1[1]; o[6] = bflo(gw.w) * v1[2]; o[7] = bfhi(gw.w) * v1[3];
                    if (ADD) { const v4u pw = *(const v4u*)(PREV + ro + bj * 128);
                        o[0] += bflo(pw.x); o[1] += bfhi(pw.x); o[2] += bflo(pw.y); o[3] += bfhi(pw.y); o[4] += bflo(pw.z); o[5] += bfhi(pw.z); o[6] += bflo(pw.w); o[7] += bfhi(pw.w); }
                    v4u w; w.x = pk2(o[0], o[1]); w.y = pk2(o[2], o[3]); w.z = pk2(o[4], o[5]); w.w = pk2(o[6], o[7]);
                    *(v4u*)(O + ro + bj * 128) = w; } }
    }
};
struct EpiF32P {
    static constexpr bool PERM = true, AFTER_DRAIN = false;
    float* T;
    __device__ __forceinline__ void operator()(const f32x4 (&acc)[2][2][4][2], const Unit& u, int wr, int wc, int fr, int fq) const {
        const int row0 = u.pm * 256 + wr * 64 + fr, col0 = u.pn * 256 + wc * 32 + 8 * fq;
#pragma unroll
        for (int ai = 0; ai < 2; ++ai)
#pragma unroll
            for (int m = 0; m < 4; ++m) { float* rowp = T + (size_t)(row0 + ai * 128 + m * 16) * D + col0;
#pragma unroll
                for (int bj = 0; bj < 2; ++bj) { *(f32x4*)(rowp + bj * 128) = acc[ai][bj][m][0]; *(f32x4*)(rowp + bj * 128 + 4) = acc[ai][bj][m][1]; } }
    }
};

__device__ __forceinline__ float ret_log_g(int h) { return log1pf(-exp2f(-5.0f - (float)h)); }

__device__ __forceinline__ void ret_kv_simple(Frame& F) {
    LAS float* Ks = (LAS float*)F.lds;
    LAS float* Vs = Ks + 64 * 64;
    const bf16* Kb = (const bf16*)(F.ws + WS_K); const bf16* Vb = (const bf16*)(F.ws + WS_V); float* KV = (float*)(F.ws + WS_KV);
    for (int it = F.bid; it < NCH * RH; it += F.G) {
        const int n = it >> 3, h = it & 7; const float lg = ret_log_g(h);
        __syncthreads();
        for (int e = F.tid; e < 64 * 64; e += NTHREADS) { const int j = e >> 6, d = e & 63; Ks[e] = bf2f(Kb[(size_t)(n * 64 + j) * RQK + h * 64 + d]) * __expf((63.0f - (float)j) * lg); }
        for (int e = F.tid; e < 64 * 128; e += NTHREADS) { const int j = e >> 7, c = e & 127; Vs[e] = bf2f(Vb[(size_t)(n * 64 + j) * RW + h * 128 + c]); }
        __syncthreads();
        const int d = F.tid >> 3, e0 = (F.tid & 7) * 16;
        float a[16];
#pragma unroll
        for (int q = 0; q < 16; ++q) a[q] = 0.f;
#pragma unroll 2
        for (int j = 0; j < 64; ++j) { const float kd = Ks[j * 64 + d];
#pragma unroll
            for (int q = 0; q < 16; ++q) a[q] += kd * Vs[j * 128 + e0 + q]; }
        float* o = KV + ((size_t)it * 64 + d) * 128 + e0;
#pragma unroll
        for (int q = 0; q < 16; ++q) o[q] = a[q];
    }
}
__device__ __forceinline__ void scans_simple(Frame& F) {
    const int gt = F.bid * NTHREADS + F.tid;
    if (gt < RH * 64 * 128) {
        const int h = gt >> 13, de = gt & 8191; const float decay = __expf(64.0f * ret_log_g(h));
        float* p = (float*)(F.ws + WS_KV) + (size_t)h * 8192 + de; float st = 0.f;
        for (int n = 0; n < NCH; ++n) { const float kv = p[(size_t)n * 65536]; p[(size_t)n * 65536] = st; st = st * decay + kv; }
    } else if (gt < RH * 64 * 128 + S5G * S5P) {
        const int gp = gt - RH * 64 * 128; const f32x2 a = ((const f32x2*)(F.ws + WS_S5AB))[4096 + gp];
        f32x2* p = (f32x2*)(F.ws + WS_S5S) + gp; float xr = 0.f, xi = 0.f;
        for (int c = 0; c < NCH; ++c) { const f32x2 s = p[(size_t)c * 4096]; p[(size_t)c * 4096] = (f32x2){xr, xi}; const float nr = a.x * xr - a.y * xi + s.x, ni = a.x * xi + a.y * xr + s.y; xr = nr; xi = ni; }
    }
}
__device__ __forceinline__ void ret_out_simple(Frame& F) {
    LAS float* Qs = (LAS float*)F.lds;
    LAS float* Ks = Qs + 64 * 65;
    LAS float* Ss = Ks + 64 * 65;
    LAS float* Vs = Ss + 64 * 65;
    LAS float* Ps = Vs + 64 * 128;
    const bf16* Qb = (const bf16*)(F.ws + WS_Q); const bf16* Kb = (const bf16*)(F.ws + WS_K); const bf16* Vb = (const bf16*)(F.ws + WS_V);
    const float* KV = (const float*)(F.ws + WS_KV); const bf16* ZR = (const bf16*)(F.ws + WS_ZR); bf16* YR = (bf16*)(F.ws + WS_YR);
    for (int it = F.bid; it < NCH * RH; it += F.G) {
        const int n = it >> 3, h = it & 7; const float lg = ret_log_g(h);
        __syncthreads();
        for (int e = F.tid; e < 64 * 64; e += NTHREADS) { const int j = e >> 6, d = e & 63; const size_t g = (size_t)(n * 64 + j) * RQK + h * 64 + d; Qs[j * 65 + d] = bf2f(Qb[g]); Ks[j * 65 + d] = bf2f(Kb[g]); }
        for (int e = F.tid; e < 64 * 128; e += NTHREADS) { const int j = e >> 7, c = e & 127; Vs[e] = bf2f(Vb[(size_t)(n * 64 + j) * RW + h * 128 + c]); Ps[e] = KV[(size_t)it * 8192 + e]; }
        __syncthreads();
        const int i = F.tid >> 3, sub = F.tid & 7;
#pragma unroll
        for (int jj = 0; jj < 8; ++jj) { const int j = sub * 8 + jj; float s = 0.f;
#pragma unroll 4
            for (int d = 0; d < 64; ++d) s += Qs[i * 65 + d] * Ks[j * 65 + d];
            const float dist = fabsf((float)(i - j)); Ss[i * 65 + j] = s * __expf(dist * lg); }
        __syncthreads();
        const int e0 = sub * 16; float o[16], cr[16];
#pragma unroll
        for (int q = 0; q < 16; ++q) { o[q] = 0.f; cr[q] = 0.f; }
#pragma unroll 1
        for (int j = 0; j < 64; ++j) { const float s = Ss[i * 65 + j], qd = Qs[i * 65 + j];
#pragma unroll
            for (int q = 0; q < 16; ++q) { o[q] += s * Vs[j * 128 + e0 + q]; cr[q] += qd * Ps[j * 128 + e0 + q]; } }
        const float xi = __expf((float)(i + 1) * lg); float ss = 0.f;
#pragma unroll
        for (int q = 0; q < 16; ++q) { o[q] += xi * cr[q]; ss += o[q] * o[q]; }
        ss += __shfl_xor(ss, 1); ss += __shfl_xor(ss, 2); ss += __shfl_xor(ss, 4);
        const float r = 1.0f / sqrtf(ss * (1.0f / 128.0f) + EPS);
        const size_t g = (size_t)(n * 64 + i) * RW + h * 128 + e0;
#pragma unroll
        for (int q = 0; q < 16; ++q) YR[g + q] = (bf16)f2bf(o[q] * r * bf2f(ZR[g + q]));
    }
}
template <int MODE> __device__ __forceinline__ void s5_simple(Frame& F) {
    const int gw = F.bid * NWAVES + F.wave, NGW = F.G * NWAVES;
    const bf16* U = (const bf16*)(F.ws + WS_U); f32x2* S = (f32x2*)(F.ws + WS_S5S); bf16* Gg = (bf16*)(F.ws + WS_G);
    const f32x2* AB = (const f32x2*)(F.ws + WS_S5AB); const f32x2* BB = (const f32x2*)(F.ws + WS_S5BB);
    for (int it = gw; it < NCH * S5G; it += NGW) {
        const int c = it >> 6, g = it & 63, p = F.lane;
        const f32x2 a = AB[g * 64 + p];
        float bbr[16], bbi[16];
#pragma unroll
        for (int h = 0; h < 16; ++h) { const f32x2 b = BB[(size_t)(g * 64 + p) * 16 + h]; bbr[h] = b.x; bbi[h] = b.y; }
        float cre[16], cim[16], dsk = 0.f;
        if (MODE == 1) {
#pragma unroll
            for (int h = 0; h < 16; ++h) { cre[h] = F.in[8][(size_t)(g * 16 + h) * 64 + p]; cim[h] = F.in[9][(size_t)(g * 16 + h) * 64 + p]; }
            dsk = F.in[10][g * 16 + (p & 15)];
        }
        float xr = 0.f, xi = 0.f;
        if (MODE == 1) { const f32x2 x0 = S[(size_t)c * 4096 + g * 64 + p]; xr = x0.x; xi = x0.y; }
#pragma unroll 1
        for (int s = 0; s < 64; ++s) {
            const size_t t = (size_t)(c * 64 + s);
            const v4u u0 = *(const v4u*)(U + t * S5W + g * 16), u1 = *(const v4u*)(U + t * S5W + g * 16 + 8);
            float uu[16] = {bflo(u0.x), bfhi(u0.x), bflo(u0.y), bfhi(u0.y), bflo(u0.z), bfhi(u0.z), bflo(u0.w), bfhi(u0.w),
                            bflo(u1.x), bfhi(u1.x), bflo(u1.y), bfhi(u1.y), bflo(u1.z), bfhi(u1.z), bflo(u1.w), bfhi(u1.w)};
            float bur = 0.f, bui = 0.f;
#pragma unroll
            for (int h = 0; h < 16; ++h) { bur += bbr[h] * uu[h]; bui += bbi[h] * uu[h]; }
            const float nr = a.x * xr - a.y * xi + bur, ni = a.x * xi + a.y * xr + bui; xr = nr; xi = ni;
            if (MODE == 1) {
                float mine = 0.f;
#pragma unroll
                for (int h = 0; h < 16; ++h) { const float y = wave_sum(cre[h] * xr - cim[h] * xi); if ((p & 15) == h) mine = y + dsk * uu[h]; }
                if (p < 16) Gg[t * S5W + g * 16 + p] = (bf16)f2bf(gelu_tanh(mine));
            }
        }
        if (MODE == 0) S[(size_t)c * 4096 + g * 64 + p] = (f32x2){xr, xi};
    }
}
__device__ __forceinline__ void final_simple(Frame& F) {
    const int gw = F.bid * NWAVES + F.wave, NGW = F.G * NWAVES;
    const float* T = (const float*)(F.ws + WS_T); const float* x = F.in[0]; const float* gain = F.in[16];
    f32x4 gv[8];
#pragma unroll
    for (int j = 0; j < 8; ++j) gv[j] = *((const f32x4*)gain + F.lane + 64 * j);
    for (int m = gw; m < M; m += NGW) {
        const f32x4* tr = (const f32x4*)(T + (size_t)m * D) + F.lane; const f32x4* xr = (const f32x4*)(x + (size_t)m * D) + F.lane;
        f32x4 v[8]; float s = 0.f;
#pragma unroll
        for (int j = 0; j < 8; ++j) { v[j] = tr[64 * j]; s += (v[j].x * v[j].x + v[j].y * v[j].y) + (v[j].z * v[j].z + v[j].w * v[j].w); }
        const float r = 1.0f / sqrtf(wave_sum(s) * (1.0f / D) + EPS);
        f32x4* o = (f32x4*)(F.out + (size_t)m * D) + F.lane;
#pragma unroll
        for (int j = 0; j < 8; ++j) o[64 * j] = xr[64 * j] + v[j] * r * gv[j];
    }
}

struct Args { const float* in[17]; float* out; unsigned char* ws; int ph_lo, ph_hi; };
constexpr int NPHASES = 10;

__global__ void __launch_bounds__(NTHREADS, 2) fwd_kernel(Args args) {
    extern __shared__ __attribute__((aligned(16))) unsigned char lds_raw[];
    Frame F;
    F.lds = (LAS unsigned char*)lds_raw;
    F.tid = threadIdx.x; F.lane = F.tid & 63; F.wave = __builtin_amdgcn_readfirstlane(F.tid >> 6);
    F.G = gridDim.x; F.bid = blockIdx.x;
#pragma unroll
    for (int i = 0; i < 17; ++i) F.in[i] = args.in[i];
    F.out = args.out; F.ws = args.ws;
    const int lo = args.ph_lo, hi = args.ph_hi;
    cg::grid_group grid = cg::this_grid();
#ifndef PHMASK
#define PHMASK 0x3ff
#endif
#define IN(k) (((PHMASK >> (k)) & 1) && lo <= (k) && (k) < hi)
#define SEAM(k) do { if (IN(k) && IN((k) + 1)) grid.sync(); } while (0)
    using pg8::bf16_t;
    if (IN(0)) { p0_prologue(F); } SEAM(0);
    if (IN(1)) {
        pg8::Gemm g{(const bf16_t*)(F.ws + WS_H), (const bf16_t*)(F.ws + WS_WIN), M, NIN, D}; pg8::StaticOrder S; S.init(M, NIN, F.G, F.bid);
        EpiIn E{F.ws};
        pg8::gemm_phase<EpiIn, pg8::StaticOrder, true, true>(F.lds, g, S, E);
    } SEAM(1);
    if (IN(2)) { ret_kv_simple(F); s5_simple<0>(F); } SEAM(2);
    if (IN(3)) { scans_simple(F); } SEAM(3);
    if (IN(4)) { ret_out_simple(F); s5_simple<1>(F); } SEAM(4);
    if (IN(5)) {
        pg8::Gemm g{(const bf16_t*)(F.ws + WS_G), (const bf16_t*)(F.ws + WS_WGLU), M, S5W, S5W}; pg8::StaticOrder S; S.init(M, S5W, F.G, F.bid);
        EpiGlu E{(const bf16*)(F.ws + WS_G), (const bf16*)(F.ws + WS_ZS), F.in[12], (bf16*)(F.ws + WS_YS)};
        pg8::gemm_phase<EpiGlu, pg8::StaticOrder, true, true>(F.lds, g, S, E);
    } SEAM(5);
    if (IN(6)) {
        pg8::Gemm g{(const bf16_t*)(F.ws + WS_YS), (const bf16_t*)(F.ws + WS_WS), M, D, S5W}; pg8::StaticOrder S; S.init(M, D, F.G, F.bid);
        EpiGate<false> E{(const bf16*)(F.ws + WS_GS), nullptr, (bf16*)(F.ws + WS_M1)};
        pg8::gemm_phase<EpiGate<false>, pg8::StaticOrder, true, true>(F.lds, g, S, E);
    } SEAM(6);
    if (IN(7)) {
        pg8::Gemm g{(const bf16_t*)(F.ws + WS_YR), (const bf16_t*)(F.ws + WS_WR), M, D, RW}; pg8::StaticOrder S; S.init(M, D, F.G, F.bid);
        EpiGate<true> E{(const bf16*)(F.ws + WS_GR), (const bf16*)(F.ws + WS_M1), (bf16*)(F.ws + WS_MM)};
        pg8::gemm_phase<EpiGate<true>, pg8::StaticOrder, true, true>(F.lds, g, S, E);
    } SEAM(7);
    if (IN(8)) {
        pg8::Gemm g{(const bf16_t*)(F.ws + WS_MM), (const bf16_t*)(F.ws + WS_WOUT), M, D, D}; pg8::StaticOrder S; S.init(M, D, F.G, F.bid);
        EpiF32P E{(float*)(F.ws + WS_T)};
        pg8::gemm_phase<EpiF32P, pg8::StaticOrder, true, true>(F.lds, g, S, E);
    } SEAM(8);
    if (IN(9)) { final_simple(F); }
#undef IN
#undef SEAM
}

#ifndef MK_PER_PHASE
#define MK_PER_PHASE 0
#endif
extern "C" void kernel_launch(void* const* d_in, const int* in_sizes, int n_in, void* d_out, int out_size, void* d_ws, size_t ws_size, hipStream_t stream) {
    static int grid = 0;
    if (grid == 0) {
        if (n_in != 17 || in_sizes[0] != M * D || out_size != M * D || ws_size < WS_END) { fprintf(stderr, "kernel_launch: unexpected shapes (n_in %d, in0 %d, out %d, ws %zu)\n", n_in, n_in > 0 ? in_sizes[0] : -1, out_size, ws_size); grid = -1; return; }
        int dev = 0, cus = 0, per_cu = 0;
        if (hipGetDevice(&dev) != hipSuccess || hipDeviceGetAttribute(&cus, hipDeviceAttributeMultiprocessorCount, dev) != hipSuccess) { grid = -1; return; }
        if (hipFuncSetAttribute((const void*)fwd_kernel, hipFuncAttributeMaxDynamicSharedMemorySize, LDS_BYTES) != hipSuccess) { fprintf(stderr, "kernel_launch: hipFuncSetAttribute failed\n"); grid = -1; return; }
        if (hipOccupancyMaxActiveBlocksPerMultiprocessor(&per_cu, (const void*)fwd_kernel, NTHREADS, LDS_BYTES) != hipSuccess || per_cu < 1) { fprintf(stderr, "kernel_launch: occupancy query says %d\n", per_cu); per_cu = 1; }
        (void)hipGetLastError();
        grid = cus;
    }
    if (grid < 0) return;
    Args a{};
    for (int i = 0; i < 17; ++i) a.in[i] = (const float*)d_in[i];
    a.out = (float*)d_out; a.ws = (unsigned char*)d_ws;
#if MK_PER_PHASE
    for (int p = 0; p < NPHASES; ++p) { a.ph_lo = p; a.ph_hi = p + 1; hipLaunchKernelGGL(fwd_kernel, dim3(grid), dim3(NTHREADS), LDS_BYTES, stream, a); }
#else
    a.ph_lo = 0; a.ph_hi = NPHASES;
    void* kargs[] = {&a};
    hipError_t e = hipLaunchCooperativeKernel((const void*)fwd_kernel, dim3(grid), dim3(NTHREADS), kargs, LDS_BYTES, stream);
    if (e != hipSuccess) fprintf(stderr, "kernel_launch: cooperative launch failed: %s (grid %d)\n", hipGetErrorString(e), grid);
#endif
}
```

```cpp
#include <hip/hip_runtime.h>
#include <hip/hip_cooperative_groups.h>
#include <cstdio>
#include <cstdint>
namespace cg = cooperative_groups;
namespace pg8 {
#define PG8_LAS __attribute__((address_space(3)))
typedef unsigned short bf16_t;
typedef short bf16x8 __attribute__((ext_vector_type(8)));
typedef float f32x4 __attribute__((ext_vector_type(4)));
typedef unsigned u32x4 __attribute__((ext_vector_type(4)));
constexpr int BM = 256, BK = 64, HALF = 128, HTB = HALF * BK * 2  , STAGE_BYTES = 8 * HTB, NXCD = 8, WGM = 8;

__host__ __device__ __forceinline__ int lds_byte(int r, int c) { const int st = (r >> 4) * 2 + (c >> 5), rr = r & 15, cc = c & 31, ob = rr * 64 + cc * 2; return st * 1024 + (ob ^ (((ob >> 9) & 1) << 5)); }
__host__ __device__ __forceinline__ void stage_rc(int b, int& R, int& C) { const int st = b / 1024, sb = b % 1024, swz = sb ^ (((sb >> 9) & 1) << 5); R = (st >> 1) * 16 + swz / 64; C = (st & 1) * 32 + (swz % 64) / 2; }
__host__ __device__ __forceinline__ int perm32(int rho) { const int n = rho >> 4, i = rho & 15; return 8 * (i >> 2) + 4 * n + (i & 3); }

struct Unit { int pm, pn; };
struct Gemm { const bf16_t* A; const bf16_t* Bt; int M, N, K; };

struct StaticOrder {
    int nM, nN, nwg, G, c;
    __host__ __device__ void init(int M, int N, int G_, int c_) { nM = M / BM; nN = N / BM; nwg = nM * nN; G = G_; c = c_; }
    __host__ __device__ bool next(int i, Unit& u) const {
        const long L = (long)i * G + c; if (L >= nwg) return false;
        int wgid = (int)L; { const int q = nwg / NXCD, r = nwg % NXCD, xcd = wgid % NXCD, off = wgid / NXCD; wgid = (xcd < r ? xcd * (q + 1) : r * (q + 1) + (xcd - r) * q) + off; }
        const int nig = WGM * nN, gid = wgid / nig, fm = gid * WGM, gsz = (nM - fm) < WGM ? (nM - fm) : WGM;
        u.pm = fm + ((wgid % nig) % gsz); u.pn = (wgid % nig) / gsz; return true;
    }
    __device__ __forceinline__ void a_ready(const Unit&) const {}
    __device__ __forceinline__ void done(const Unit&) const {}
};

__device__ __forceinline__ unsigned cvt_pk_bf16(float lo, float hi) { unsigned r; asm volatile("v_cvt_pk_bf16_f32 %0, %1, %2" : "=v"(r) : "v"(lo), "v"(hi)); return r; }
typedef float f32x2 __attribute__((ext_vector_type(2)));
__device__ __forceinline__ f32x2 gelu_pk(f32x2 v) {
    const f32x2 av = __builtin_elementwise_abs(v), d = av * 0.2316418882f + 1.0f;
    f32x2 t; t.x = __builtin_amdgcn_rcpf(d.x); t.y = __builtin_amdgcn_rcpf(d.y);
    f32x2 q = t * 0.5307027145f + (-0.7265760135f); q = q * t + 0.7107068705f; q = q * t + (-0.142248368f); q = q * t + 0.127414796f; q = q * t;
    const f32x2 s = (v * v) * (-0.72134752044f);
    f32x2 e; e.x = __builtin_amdgcn_exp2f(s.x); e.y = __builtin_amdgcn_exp2f(s.y);
    const f32x2 m = v * (q * e), r = v - m;
    f32x2 o; o.x = v.x < 0.f ? m.x : r.x; o.y = v.y < 0.f ? m.y : r.y; return o;
}

template <int ACT  > struct EpiBf16 {
    static constexpr bool PERM = true, AFTER_DRAIN = false; static_assert(ACT == 0 || ACT == 1, "EpiBf16: ACT is 0 (none) or 1 (gelu_pk)");
    bf16_t* O; int ldc; const float* bias; int split_cols; size_t split_stride; float scale0;
    __device__ __forceinline__ void operator()(const f32x4 (&acc)[2][2][4][2], const Unit& u, int wr, int wc, int fr, int fq) const {
        const int row0 = u.pm * BM + wr * 64 + fr; int colt = u.pn * BM; bf16_t* base = O;
        float sc = 1.f; if (split_cols) { const int t = colt / split_cols; base += (size_t)t * split_stride; colt -= t * split_cols; if (t == 0) sc = scale0; }
        const int col0 = colt + wc * 32 + 8 * fq, bcol0 = u.pn * BM + wc * 32 + 8 * fq;
        f32x4 bv[2][2];
#pragma unroll
        for (int bj = 0; bj < 2; ++bj)
#pragma unroll
            for (int n = 0; n < 2; ++n) bv[bj][n] = bias ? *(const f32x4*)(bias + bcol0 + bj * HALF + 4 * n) : (f32x4){0.f, 0.f, 0.f, 0.f};
#pragma unroll
        for (int ai = 0; ai < 2; ++ai)
#pragma unroll
            for (int m = 0; m < 4; ++m) { bf16_t* rowp = base + (size_t)(row0 + ai * HALF + m * 16) * ldc + col0;
#pragma unroll
                for (int bj = 0; bj < 2; ++bj) { f32x4 v0 = acc[ai][bj][m][0] + bv[bj][0], v1 = acc[ai][bj][m][1] + bv[bj][1];
                    if (ACT == 1) { f32x2 a = gelu_pk((f32x2){v0[0], v0[1]}), b = gelu_pk((f32x2){v0[2], v0[3]}), c = gelu_pk((f32x2){v1[0], v1[1]}), d = gelu_pk((f32x2){v1[2], v1[3]});
                        v0 = (f32x4){a.x, a.y, b.x, b.y}; v1 = (f32x4){c.x, c.y, d.x, d.y}; }
                    v0 = v0 * sc; v1 = v1 * sc; u32x4 w; w.x = cvt_pk_bf16(v0[0], v0[1]); w.y = cvt_pk_bf16(v0[2], v0[3]); w.z = cvt_pk_bf16(v1[0], v1[1]); w.w = cvt_pk_bf16(v1[2], v1[3]);
                    *(u32x4*)(rowp + bj * HALF) = w; } }
    }
};

template <class Epi, class Sched, bool ALIGN_EPI = false, bool SP2 = false>
__device__ __forceinline__ void gemm_phase(PG8_LAS unsigned char* lds, const Gemm g, const Sched& S, const Epi& E) {
    const int tid = threadIdx.x, wid = __builtin_amdgcn_readfirstlane(tid >> 6), lane = tid & 63, wr = wid >> 2, wc = wid & 3, fr = lane & 15, fq = lane >> 4;
    const int K = g.K, nt = K / BK;
    unsigned voffA[2], voffB[2];
#pragma unroll
    for (int i = 0; i < 2; ++i) { int R, C; stage_rc(tid * 16 + i * 8192, R, C); const int Rb = Epi::PERM ? ((R & ~31) + perm32(R & 31)) : R;
        voffA[i] = (unsigned)(R * K + C) * 2u; voffB[i] = (unsigned)(Rb * K + C) * 2u; }
    const size_t kstep = (size_t)(BK * 2);
    const size_t hstep = (size_t)HALF * K * 2;
    const size_t tstep = 2 * hstep;
    const unsigned ldsw = (unsigned)wid * 1024u;
    const int aoff = lds_byte(wr * 64 + fr, fq * 8), boff = lds_byte(wc * 32 + fr, fq * 8);
#define PG8_SA(b, h) (((b) * 2 + (h)) * HTB)
#define PG8_SB(b, h) ((4 + (b) * 2 + (h)) * HTB)
#define PG8_STAGE(bufoff, gbase, voff) do { _Pragma("unroll") for (int _i = 0; _i < 2; ++_i) \
        __builtin_amdgcn_global_load_lds((const unsigned*)((const char*)(gbase) + (voff)[_i]), (PG8_LAS unsigned*)(lds + (bufoff) + ldsw + _i * 8192), 16, 0, 0); } while (0)
#define PG8_LDA(dst, b, h) do { _Pragma("unroll") for (int m = 0; m < 4; ++m) _Pragma("unroll") for (int k = 0; k < 2; ++k) dst[m][k] = *(const PG8_LAS bf16x8*)(lds + PG8_SA(b, h) + aoff + m * 2048 + k * 1024); } while (0)
#define PG8_LDB(dst, b, h) do { _Pragma("unroll") for (int n = 0; n < 2; ++n) _Pragma("unroll") for (int k = 0; k < 2; ++k) dst[n][k] = *(const PG8_LAS bf16x8*)(lds + PG8_SB(b, h) + boff + n * 2048 + k * 1024); } while (0)
#define PG8_MMA(ai, bj, At, Bt) do { __builtin_amdgcn_s_setprio(1); _Pragma("unroll") for (int m = 0; m < 4; ++m) _Pragma("unroll") for (int n = 0; n < 2; ++n) _Pragma("unroll") for (int k = 0; k < 2; ++k) \
        acc[ai][bj][m][n] = __builtin_amdgcn_mfma_f32_16x16x32_bf16(Bt[n][k], At[m][k], acc[ai][bj][m][n], 0, 0, 0); __builtin_amdgcn_s_setprio(0); } while (0)
#define PG8_WAIT_V(n) asm volatile("s_waitcnt vmcnt(" #n ")" ::: "memory")
#define PG8_WAIT_L(n) asm volatile("s_waitcnt lgkmcnt(" #n ")" ::: "memory")
#define PG8_BAR __builtin_amdgcn_s_barrier()
#define PG8_SCHED __builtin_amdgcn_sched_barrier(0)
    Unit cur, nxt; int ui = 0;
    if (!S.next(0, cur)) return;
    f32x4 acc[2][2][4][2];
#pragma unroll
    for (int a = 0; a < 2; ++a)
#pragma unroll
        for (int b = 0; b < 2; ++b)
#pragma unroll
            for (int m = 0; m < 4; ++m)
#pragma unroll
                for (int n = 0; n < 2; ++n) acc[a][b][m][n] = (f32x4){0.f, 0.f, 0.f, 0.f};
    bf16x8 At[4][2], B0[2][2], B1[2][2];
    const char* cA = (const char*)g.A + (size_t)cur.pm * tstep; const char* cB = (const char*)g.Bt + (size_t)cur.pn * tstep;
    S.a_ready(cur);
    if constexpr (SP2) {
        PG8_STAGE(PG8_SB(0, 0), cB, voffB); PG8_STAGE(PG8_SB(0, 1), cB + hstep, voffB); PG8_STAGE(PG8_SA(0, 0), cA, voffA); PG8_STAGE(PG8_SA(0, 1), cA + hstep, voffA);
        if (wr == 1) PG8_BAR;
        PG8_WAIT_V(2); PG8_BAR;
        PG8_STAGE(PG8_SB(1, 0), cB + kstep, voffB); PG8_STAGE(PG8_SA(1, 0), cA + kstep, voffA); PG8_STAGE(PG8_SB(1, 1), cB + hstep + kstep, voffB);
        PG8_WAIT_V(6); PG8_BAR;
    } else {
        PG8_STAGE(PG8_SB(0, 0), cB, voffB); PG8_STAGE(PG8_SA(0, 0), cA, voffA); PG8_STAGE(PG8_SB(0, 1), cB + hstep, voffB); PG8_STAGE(PG8_SA(0, 1), cA + hstep, voffA);
        if (wr == 1) PG8_BAR;
        PG8_WAIT_V(4); PG8_BAR;
        PG8_STAGE(PG8_SB(1, 0), cB + kstep, voffB); PG8_STAGE(PG8_SA(1, 0), cA + kstep, voffA); PG8_STAGE(PG8_SB(1, 1), cB + hstep + kstep, voffB);
        PG8_WAIT_V(6); PG8_BAR;
    }
    for (;;) {
        const bool has_next = S.next(ui + 1, nxt);
        const char* nA = has_next ? (const char*)g.A + (size_t)nxt.pm * tstep : cA; const char* nB = has_next ? (const char*)g.Bt + (size_t)nxt.pn * tstep : cB;
        for (int t = 0; t < nt; t += 2) {
            const bool last = (t == nt - 2);
            const char* a1 = cA + (size_t)(t + 1) * kstep;
            const char* a2 = last ? nA : cA + (size_t)(t + 2) * kstep; const char* b2 = last ? nB : cB + (size_t)(t + 2) * kstep;
            const char* a3 = a2 + kstep; const char* b3 = b2 + kstep;
            if (last && has_next) S.a_ready(nxt);
            if constexpr (SP2) {
            PG8_LDB(B0, 0, 0); PG8_LDB(B1, 0, 1); PG8_SCHED; PG8_LDA(At, 0, 0); PG8_STAGE(PG8_SA(1, 1), a1 + hstep, voffA);
            PG8_WAIT_V(8); PG8_WAIT_L(0); PG8_BAR; PG8_MMA(0, 0, At, B0); PG8_MMA(0, 1, At, B1); PG8_BAR; PG8_SCHED;
            PG8_LDA(At, 0, 1); PG8_STAGE(PG8_SB(0, 0), b2, voffB); PG8_STAGE(PG8_SB(0, 1), b2 + hstep, voffB); PG8_STAGE(PG8_SA(0, 0), a2, voffA);
            PG8_WAIT_V(8); PG8_WAIT_L(0); PG8_BAR; PG8_MMA(1, 0, At, B0); PG8_MMA(1, 1, At, B1); PG8_BAR; PG8_SCHED;
            PG8_LDB(B0, 1, 0); PG8_LDB(B1, 1, 1); PG8_SCHED; PG8_LDA(At, 1, 0); PG8_STAGE(PG8_SA(0, 1), a2 + hstep, voffA);
            PG8_WAIT_V(8); PG8_WAIT_L(0); PG8_BAR; PG8_MMA(0, 0, At, B0); PG8_MMA(0, 1, At, B1); PG8_BAR; PG8_SCHED;
            PG8_LDA(At, 1, 1); PG8_STAGE(PG8_SB(1, 0), b3, voffB); PG8_STAGE(PG8_SB(1, 1), b3 + hstep, voffB); PG8_STAGE(PG8_SA(1, 0), a3, voffA);
            PG8_WAIT_V(8); PG8_WAIT_L(0); PG8_BAR; PG8_MMA(1, 0, At, B0); PG8_MMA(1, 1, At, B1); PG8_BAR; PG8_SCHED;
            } else {
            PG8_LDB(B0, 0, 0); PG8_SCHED; PG8_LDA(At, 0, 0); PG8_STAGE(PG8_SA(1, 1), a1 + hstep, voffA);
            PG8_WAIT_L(8); PG8_BAR; PG8_WAIT_L(0); PG8_MMA(0, 0, At, B0); PG8_BAR; PG8_SCHED;
            PG8_LDB(B1, 0, 1); PG8_STAGE(PG8_SB(0, 0), b2, voffB);
            PG8_BAR; PG8_WAIT_L(0); PG8_MMA(0, 1, At, B1); PG8_BAR;
            PG8_LDA(At, 0, 1); PG8_STAGE(PG8_SA(0, 0), a2, voffA);
            PG8_BAR; PG8_WAIT_L(0); PG8_MMA(1, 0, At, B0); PG8_BAR; PG8_SCHED;
            PG8_STAGE(PG8_SB(0, 1), b2 + hstep, voffB);
            PG8_WAIT_V(6); PG8_BAR; PG8_MMA(1, 1, At, B1); PG8_BAR;
            PG8_LDB(B0, 1, 0); PG8_SCHED; PG8_LDA(At, 1, 0); PG8_STAGE(PG8_SA(0, 1), a2 + hstep, voffA);
            PG8_WAIT_L(8); PG8_BAR; PG8_WAIT_L(0); PG8_MMA(0, 0, At, B0); PG8_BAR; PG8_SCHED;
            PG8_LDB(B1, 1, 1); PG8_STAGE(PG8_SB(1, 0), b3, voffB);
            PG8_BAR; PG8_WAIT_L(0); PG8_MMA(0, 1, At, B1); PG8_BAR;
            PG8_LDA(At, 1, 1); PG8_STAGE(PG8_SA(1, 0), a3, voffA);
            PG8_BAR; PG8_WAIT_L(0); PG8_MMA(1, 0, At, B0); PG8_BAR; PG8_SCHED;
            PG8_STAGE(PG8_SB(1, 1), b3 + hstep, voffB);
            PG8_WAIT_V(6); PG8_BAR; PG8_MMA(1, 1, At, B1); PG8_BAR;
            }
        }
        if constexpr (ALIGN_EPI) { if (wr == 0) PG8_BAR; }
        if constexpr (!Epi::AFTER_DRAIN) { E(acc, cur, wr, wc, fr, fq); S.done(cur); }
        if (!has_next) break;
#pragma unroll
        for (int a = 0; a < 2; ++a)
#pragma unroll
            for (int b = 0; b < 2; ++b)
#pragma unroll
                for (int m = 0; m < 4; ++m)
#pragma unroll
                    for (int n = 0; n < 2; ++n) acc[a][b][m][n] = (f32x4){0.f, 0.f, 0.f, 0.f};
        cur = nxt; cA = nA; cB = nB; ++ui;
        if constexpr (ALIGN_EPI) { if (wr == 1) PG8_BAR; }
    }
    PG8_WAIT_V(0);
    if constexpr (!ALIGN_EPI) { if (wr == 0) PG8_BAR; }
    PG8_BAR;
    if constexpr (Epi::AFTER_DRAIN) { E.fused(acc, cur, wr, wc, fr, fq, lds, wid, lane); S.done(cur); }
#undef PG8_SA
#undef PG8_SB
#undef PG8_STAGE
#undef PG8_LDA
#undef PG8_LDB
#undef PG8_MMA
#undef PG8_WAIT_V
#undef PG8_WAIT_L
#undef PG8_BAR
#undef PG8_SCHED
}
}

#define GAS __attribute__((address_space(1)))
#define LAS __attribute__((address_space(3)))
typedef unsigned short bf16;
typedef unsigned v4u __attribute__((ext_vector_type(4)));
typedef unsigned v2u __attribute__((ext_vector_type(2)));
typedef float f32x4 __attribute__((ext_vector_type(4)));
typedef float f32x2 __attribute__((ext_vector_type(2)));

constexpr int NWAVES = 8, NTHREADS = 512;
constexpr int M = 16384, D = 2048, NIN = 9216;
constexpr int S5W = 1024, S5G = 64, S5H = 16, S5P = 64;
constexpr int RH = 8, RDK = 64, RDV = 128, RQK = 512, RW = 1024, CH = 64, NCH = M / CH;
constexpr float EPS = 1e-6f;

constexpr size_t MiB = 1u << 20;
constexpr size_t WS_CTL = 0;
constexpr size_t WS_WIN = 1 * MiB;
constexpr size_t WS_WGLU = 37 * MiB;
constexpr size_t WS_WS = 39 * MiB;
constexpr size_t WS_WR = 43 * MiB;
constexpr size_t WS_WOUT = 47 * MiB;
constexpr size_t WS_ROT = 55 * MiB;
constexpr size_t WS_S5AB = 59 * MiB;
constexpr size_t WS_S5BB = 59 * MiB + 65536;
constexpr size_t WS_H = 64 * MiB;
constexpr size_t WS_G = 64 * MiB, WS_YR = 96 * MiB;
constexpr size_t WS_U = 128 * MiB;
constexpr size_t WS_YS = 128 * MiB;
constexpr size_t WS_ZS = 160 * MiB;
constexpr size_t WS_Q = 192 * MiB;
constexpr size_t WS_K = 208 * MiB;
constexpr size_t WS_V = 224 * MiB;
constexpr size_t WS_M1 = 192 * MiB;
constexpr size_t WS_ZR = 256 * MiB;
constexpr size_t WS_GS = 288 * MiB;
constexpr size_t WS_GR = 352 * MiB;
constexpr size_t WS_KV = 416 * MiB;
constexpr size_t WS_MM = 416 * MiB;
constexpr size_t WS_S5S = 480 * MiB;
constexpr size_t WS_T = 160 * MiB;
constexpr size_t WS_TK = 60 * MiB;
constexpr size_t WS_TV = 488 * MiB;
constexpr size_t WS_XP = 504 * MiB;
constexpr size_t WS_END = 508 * MiB;

constexpr int LDS_BYTES = 147456;

__device__ __forceinline__ unsigned f2bf(float f) { unsigned u = __builtin_bit_cast(unsigned, f); return (u + 0x7fffu + ((u >> 16) & 1u)) >> 16; }
__device__ __forceinline__ unsigned pk2(float lo, float hi) { return f2bf(lo) | (f2bf(hi) << 16); }
__device__ __forceinline__ float bf2f(unsigned short b) { return __builtin_bit_cast(float, ((unsigned)b) << 16); }
__device__ __forceinline__ float bflo(unsigned w) { return __builtin_bit_cast(float, w << 16); }
__device__ __forceinline__ float bfhi(unsigned w) { return __builtin_bit_cast(float, w & 0xffff0000u); }
__device__ __forceinline__ float sigmoidf_(float z) { return __builtin_amdgcn_rcpf(1.0f + __expf(-z)); }
__device__ __forceinline__ float siluf_(float z) { return z * sigmoidf_(z); }
__device__ __forceinline__ float gelu_tanh(float x) {
    const float t = 1.5957691216057308f * (x + 0.044715f * x * x * x);
    return x * sigmoidf_(t);
}
__device__ __forceinline__ float wave_sum(float v) {
#pragma unroll
    for (int o = 1; o < 64; o <<= 1) v += __shfl_xor(v, o);
    return v;
}

struct Frame {
    LAS unsigned char* lds;
    int tid, lane, wave, G, bid;
    const float* in[17];
    float* out;
    unsigned char* ws;
};

__device__ __forceinline__ void p0_transpose_item(const float* W, int K, int N, bf16* WT, int dest_row0, LAS float* scr, int k0, int n0, int lane) {
#pragma unroll 8
    for (int i = 0; i < 32; ++i) { const int kk = 2 * i + (lane >> 5); scr[kk * 33 + (lane & 31)] = W[(size_t)(k0 + kk) * N + n0 + (lane & 31)]; }
    asm volatile("s_waitcnt lgkmcnt(0)" ::: "memory");
    const int c = lane & 7;
#pragma unroll
    for (int j = 0; j < 4; ++j) { const int n = (lane >> 3) + 8 * j; const LAS float* s = scr + (8 * c) * 33 + n;
        v4u o; o.x = pk2(s[0 * 33], s[1 * 33]); o.y = pk2(s[2 * 33], s[3 * 33]); o.z = pk2(s[4 * 33], s[5 * 33]); o.w = pk2(s[6 * 33], s[7 * 33]);
        *(v4u*)(WT + (size_t)(dest_row0 + n) * K + k0 + 8 * c) = o; }
    asm volatile("s_waitcnt lgkmcnt(0)" ::: "memory");
}
__device__ __forceinline__ int win_dest_row(int n0) {
    if (n0 < 2048 || n0 >= 3072) return n0;
    const int w = n0 - 2048, T = w >> 8, r = w & 255, hh = r >> 6, s = (r >> 5) & 1;
    return 2048 + 256 * T + 128 * s + 32 * hh;
}
__device__ __forceinline__ void p0_prologue(Frame& F) {
    LAS float* scr = (LAS float*)(F.lds + F.wave * 16384);
    const int gw = F.bid * NWAVES + F.wave, NGW = F.G * NWAVES;
    bf16* WIN = (bf16*)(F.ws + WS_WIN); bf16* WGLU = (bf16*)(F.ws + WS_WGLU); bf16* WSs = (bf16*)(F.ws + WS_WS); bf16* WRr = (bf16*)(F.ws + WS_WR); bf16* WOUT = (bf16*)(F.ws + WS_WOUT);
    constexpr int I_IN = (D / 64) * (NIN / 32), I_GLU = (S5W / 64) * (S5W / 32), I_S = (S5W / 64) * (D / 32), I_R = (RW / 64) * (D / 32), I_OUT = (D / 64) * (D / 32);
    constexpr int NITEMS = I_IN + I_GLU + I_S + I_R + I_OUT;
    for (int it = gw; it < NITEMS; it += NGW) {
        int r = it;
        if (r < I_IN) { const int nb = NIN / 32, kb = r / nb, n0 = 32 * (r % nb); p0_transpose_item(F.in[2], D, NIN, WIN, win_dest_row(n0), scr, 64 * kb, n0, F.lane); continue; } r -= I_IN;
        if (r < I_GLU) { const int nb = S5W / 32, kb = r / nb, n0 = 32 * (r % nb); p0_transpose_item(F.in[11], S5W, S5W, WGLU, n0, scr, 64 * kb, n0, F.lane); continue; } r -= I_GLU;
        if (r < I_S) { const int nb = D / 32, kb = r / nb, n0 = 32 * (r % nb); p0_transpose_item(F.in[13], S5W, D, WSs, n0, scr, 64 * kb, n0, F.lane); continue; } r -= I_S;
        if (r < I_R) { const int nb = D / 32, kb = r / nb, n0 = 32 * (r % nb); p0_transpose_item(F.in[14], RW, D, WRr, n0, scr, 64 * kb, n0, F.lane); continue; } r -= I_R;
        { const int nb = D / 32, kb = r / nb, n0 = 32 * (r % nb); p0_transpose_item(F.in[15], D, D, WOUT, n0, scr, 64 * kb, n0, F.lane); }
    }
    {
        const float* x = F.in[0]; const float* gain = F.in[1]; bf16* H = (bf16*)(F.ws + WS_H);
        f32x4 gv[8];
#pragma unroll
        for (int j = 0; j < 8; ++j) gv[j] = *((const f32x4*)gain + F.lane + 64 * j);
        for (int m = gw; m < M; m += NGW) {
            const f32x4* xr = (const f32x4*)(x + (size_t)m * D) + F.lane;
            f32x4 v[8]; float s = 0.f;
#pragma unroll
            for (int j = 0; j < 8; ++j) { v[j] = xr[64 * j]; s += (v[j].x * v[j].x + v[j].y * v[j].y) + (v[j].z * v[j].z + v[j].w * v[j].w); }
            const float r = 1.0f / sqrtf(wave_sum(s) * (1.0f / D) + EPS);
            v2u* o8 = (v2u*)(H + (size_t)m * D) + F.lane;
#pragma unroll
            for (int j = 0; j < 8; ++j) { v2u w; w.x = pk2(v[j].x * r * gv[j].x, v[j].y * r * gv[j].y); w.y = pk2(v[j].z * r * gv[j].z, v[j].w * r * gv[j].w); o8[64 * j] = w; }
        }
    }
    {
        f32x2* rot = (f32x2*)(F.ws + WS_ROT);
        const int gt = F.bid * NTHREADS + F.tid, NGT = F.G * NTHREADS;
        for (int idx = gt; idx < M * 32; idx += NGT) {
            const int pos = idx >> 5, i = idx & 31;
            const float inv = exp2f(-(float)i * (13.287712379549449f / 32.0f));
            const float ang = (float)pos * inv;
            const double rev = (double)ang * 0.15915494309189535;
            const float fr = (float)(rev - __builtin_rint(rev));
            rot[idx] = (f32x2){__builtin_amdgcn_cosf(fr), __builtin_amdgcn_sinf(fr)};
        }
    }
    {
        const int gt = F.bid * NTHREADS + F.tid;
        if (gt < S5G * S5P) {
            const int g = gt >> 6;
            const float lr = F.in[3][gt], li = F.in[4][gt], step = __expf(F.in[5][g]);
            const float mag = __expf(lr * step), ang = li * step;
            const double rev = (double)ang * 0.15915494309189535;
            const float fr = (float)(rev - __builtin_rint(rev));
            const float abr = mag * __builtin_amdgcn_cosf(fr), abi = mag * __builtin_amdgcn_sinf(fr);
            const float den = lr * lr + li * li, nr = abr - 1.0f;
            const float fre = (nr * lr + abi * li) / den, fim = (abi * lr - nr * li) / den;
            f32x2* ab = (f32x2*)(F.ws + WS_S5AB);
            ab[gt] = (f32x2){abr, abi};
            float pr = abr, pi = abi;
#pragma unroll
            for (int q = 0; q < 6; ++q) { const float nr2 = pr * pr - pi * pi, ni2 = 2.0f * pr * pi; pr = nr2; pi = ni2; }
            ab[4096 + gt] = (f32x2){pr, pi};
            f32x2* bb = (f32x2*)(F.ws + WS_S5BB) + (size_t)gt * 16;
            const float* bre = F.in[6] + (size_t)gt * 16; const float* bim = F.in[7] + (size_t)gt * 16;
#pragma unroll
            for (int h = 0; h < 16; ++h) { const float br = bre[h], bi = bim[h]; bb[h] = (f32x2){fre * br - fim * bi, fre * bi + fim * br}; }
        }
    }
}

using pg8::Unit;
struct EpiIn {
    static constexpr bool PERM = true, AFTER_DRAIN = false;
    unsigned char* ws;
    __device__ __forceinline__ void operator()(const f32x4 (&acc)[2][2][4][2], const Unit& u, int wr, int wc, int fr, int fq) const {
        const int pn = u.pn, row0 = u.pm * 256 + wr * 64 + fr;
        if (pn >= 8 && pn < 12) {
            bf16* base = (bf16*)(ws + (pn < 10 ? WS_Q : WS_K)); const float sc = pn < 10 ? 1.0f : 0.125f;
            const int col0 = (pn & 1) * 256 + 64 * wc + 8 * fq;
            const f32x2* rot = (const f32x2*)(ws + WS_ROT);
#pragma unroll
            for (int ai = 0; ai < 2; ++ai)
#pragma unroll
                for (int m = 0; m < 4; ++m) {
                    const int row = row0 + ai * 128 + m * 16;
                    const f32x4* rp = (const f32x4*)(rot + (size_t)row * 32 + 8 * fq);
                    const f32x4 r0 = rp[0], r1 = rp[1], r2 = rp[2], r3 = rp[3];
                    const float cs[8] = {r0.x, r0.z, r1.x, r1.z, r2.x, r2.z, r3.x, r3.z};
                    const float sn[8] = {r0.y, r0.w, r1.y, r1.w, r2.y, r2.w, r3.y, r3.w};
                    float o1[8], o2[8];
#pragma unroll
                    for (int n = 0; n < 2; ++n)
#pragma unroll
                        for (int j = 0; j < 4; ++j) { const float t1 = acc[ai][0][m][n][j], t2 = acc[ai][1][m][n][j], c = cs[4 * n + j], s = sn[4 * n + j];
                            o1[4 * n + j] = (t1 * c - t2 * s) * sc; o2[4 * n + j] = (t1 * s + t2 * c) * sc; }
                    bf16* rowp = base + (size_t)row * RQK + col0;
                    v4u w1, w2;
                    w1.x = pk2(o1[0], o1[1]); w1.y = pk2(o1[2], o1[3]); w1.z = pk2(o1[4], o1[5]); w1.w = pk2(o1[6], o1[7]);
                    w2.x = pk2(o2[0], o2[1]); w2.y = pk2(o2[2], o2[3]); w2.z = pk2(o2[4], o2[5]); w2.w = pk2(o2[6], o2[7]);
                    *(v4u*)rowp = w1; *(v4u*)(rowp + 32) = w2;
                }
            return;
        }
        if (pn < 4) {
            bf16* base = (bf16*)(ws + WS_U);
#pragma unroll
            for (int ai = 0; ai < 2; ++ai)
#pragma unroll
                for (int m = 0; m < 4; ++m) { const int row = row0 + ai * 128 + m * 16;
#pragma unroll
                    for (int bj = 0; bj < 2; ++bj) { const int col = pn * 256 + bj * 128 + wc * 32 + 8 * fq; const f32x4 v0 = acc[ai][bj][m][0], v1 = acc[ai][bj][m][1];
                        v4u w; w.x = pk2(v0[0], v0[1]); w.y = pk2(v0[2], v0[3]); w.z = pk2(v1[0], v1[1]); w.w = pk2(v1[2], v1[3]);
                        *(v4u*)(base + ((size_t)(col >> 4) * M + row) * 16 + (col & 8)) = w; } }
            return;
        }
        bf16* base; int ld, ct, act;
        if (pn < 8) { base = (bf16*)(ws + WS_ZS); ld = 1024; ct = pn - 4; act = 1; }
        else if (pn < 16) { base = (bf16*)(ws + WS_V); ld = 1024; ct = pn - 12; act = 0; }
        else if (pn < 20) { base = (bf16*)(ws + WS_ZR); ld = 1024; ct = pn - 16; act = 1; }
        else if (pn < 28) { base = (bf16*)(ws + WS_GS); ld = 2048; ct = pn - 20; act = 2; }
        else { base = (bf16*)(ws + WS_GR); ld = 2048; ct = pn - 28; act = 2; }
        const int col0 = ct * 256 + wc * 32 + 8 * fq;
#pragma unroll
        for (int ai = 0; ai < 2; ++ai)
#pragma unroll
            for (int m = 0; m < 4; ++m) { bf16* rowp = base + (size_t)(row0 + ai * 128 + m * 16) * ld + col0;
#pragma unroll
                for (int bj = 0; bj < 2; ++bj) { f32x4 v0 = acc[ai][bj][m][0], v1 = acc[ai][bj][m][1];
                    if (act == 1) {
#pragma unroll
                        for (int j = 0; j < 4; ++j) { v0[j] = siluf_(v0[j]); v1[j] = siluf_(v1[j]); } }
                    if (act == 2) {
#pragma unroll
                        for (int j = 0; j < 4; ++j) { v0[j] = sigmoidf_(v0[j]); v1[j] = sigmoidf_(v1[j]); } }
                    v4u w; w.x = pk2(v0[0], v0[1]); w.y = pk2(v0[2], v0[3]); w.z = pk2(v1[0], v1[1]); w.w = pk2(v1[2], v1[3]);
                    *(v4u*)(rowp + bj * 128) = w; } }
    }
};
struct EpiGlu {
    static constexpr bool PERM = true, AFTER_DRAIN = false;
    const bf16* G; const bf16* ZS; const float* bias; bf16* YS;
    __device__ __forceinline__ void operator()(const f32x4 (&acc)[2][2][4][2], const Unit& u, int wr, int wc, int fr, int fq) const {
        const int row0 = u.pm * 256 + wr * 64 + fr, col0 = u.pn * 256 + wc * 32 + 8 * fq;
#pragma unroll
        for (int ai = 0; ai < 2; ++ai)
#pragma unroll
            for (int m = 0; m < 4; ++m) { const size_t ro = (size_t)(row0 + ai * 128 + m * 16) * S5W + col0;
#pragma unroll
                for (int bj = 0; bj < 2; ++bj) {
                    const v4u gw = *(const v4u*)(G + ro + bj * 128), zw = *(const v4u*)(ZS + ro + bj * 128);
                    const f32x4 b0 = *(const f32x4*)(bias + col0 + bj * 128), b1 = *(const f32x4*)(bias + col0 + bj * 128 + 4);
                    const f32x4 v0 = acc[ai][bj][m][0] + b0, v1 = acc[ai][bj][m][1] + b1;
                    float o[8];
                    o[0] = bflo(gw.x) * sigmoidf_(v0[0]) * bflo(zw.x); o[1] = bfhi(gw.x) * sigmoidf_(v0[1]) * bfhi(zw.x);
                    o[2] = bflo(gw.y) * sigmoidf_(v0[2]) * bflo(zw.y); o[3] = bfhi(gw.y) * sigmoidf_(v0[3]) * bfhi(zw.y);
                    o[4] = bflo(gw.z) * sigmoidf_(v1[0]) * bflo(zw.z); o[5] = bfhi(gw.z) * sigmoidf_(v1[1]) * bfhi(zw.z);
                    o[6] = bflo(gw.w) * sigmoidf_(v1[2]) * bflo(zw.w); o[7] = bfhi(gw.w) * sigmoidf_(v1[3]) * bfhi(zw.w);
                    v4u w; w.x = pk2(o[0], o[1]); w.y = pk2(o[2], o[3]); w.z = pk2(o[4], o[5]); w.w = pk2(o[6], o[7]);
                    *(v4u*)(YS + ro + bj * 128) = w; } }
    }
};
template <bool ADD> struct EpiGate {
    static constexpr bool PERM = true, AFTER_DRAIN = false;
    const bf16* GATE; const bf16* PREV; bf16* O;
    __device__ __forceinline__ void operator()(const f32x4 (&acc)[2][2][4][2], const Unit& u, int wr, int wc, int fr, int fq) const {
        const int row0 = u.pm * 256 + wr * 64 + fr, col0 = u.pn * 256 + wc * 32 + 8 * fq;
#pragma unroll
        for (int ai = 0; ai < 2; ++ai)
#pragma unroll
            for (int m = 0; m < 4; ++m) { const size_t ro = (size_t)(row0 + ai * 128 + m * 16) * D + col0;
#pragma unroll
                for (int bj = 0; bj < 2; ++bj) {
                    const v4u gw = *(const v4u*)(GATE + ro + bj * 128);
                    const f32x4 v0 = acc[ai][bj][m][0], v1 = acc[ai][bj][m][1];
                    float o[8];
                    o[0] = bflo(gw.x) * v0[0]; o[1] = bfhi(gw.x) * v0[1]; o[2] = bflo(gw.y) * v0[2]; o[3] = bfhi(gw.y) * v0[3];
                    o[4] = bflo(gw.z) * v1[0]; o[5] = bfhi(gw.z) * v1[1]; o[6] = bflo(gw.w) * v1[2]; o[7] = bfhi(gw.w) * v1[3];
                    if (ADD) { const v4u pw = *(const v4u*)(PREV + ro + bj * 128);
                        o[0] += bflo(pw.x); o[1] += bfhi(pw.x); o[2] += bflo(pw.y); o[3] += bfhi(pw.y); o[4] += bflo(pw.z); o[5] += bfhi(pw.z); o[6] += bflo(pw.w); o[7] += bfhi(pw.w); }
                    v4u w; w.x = pk2(o[0], o[1]); w.y = pk2(o[2], o[3]); w.z = pk2(o[4], o[5]); w.w = pk2(o[6], o[7]);
                    *(v4u*)(O + ro + bj * 128) = w; } }
    }
};
struct EpiF32P {
    static constexpr bool PERM = true, AFTER_DRAIN = false;
    float* T;
    __device__ __forceinline__ void operator()(const f32x4 (&acc)[2][2][4][2], const Unit& u, int wr, int wc, int fr, int fq) const {
        const int row0 = u.pm * 256 + wr * 64 + fr, col0 = u.pn * 256 + wc * 32 + 8 * fq;
#pragma unroll
        for (int ai = 0; ai < 2; ++ai)
#pragma unroll
            for (int m = 0; m < 4; ++m) { float* rowp = T + (size_t)(row0 + ai * 128 + m * 16) * D + col0;
#pragma unroll
                for (int bj = 0; bj < 2; ++bj) { *(f32x4*)(rowp + bj * 128) = acc[ai][bj][m][0]; *(f32x4*)(rowp + bj * 128 + 4) = acc[ai][bj][m][1]; } }
    }
};

__device__ __forceinline__ float ret_log_g(int h) { return log1pf(-exp2f(-5.0f - (float)h)); }

__device__ __forceinline__ void ret_kv_simple(Frame& F) {
    LAS float* Ks = (LAS float*)F.lds;
    LAS float* Vs = Ks + 64 * 64;
    const bf16* Kb = (const bf16*)(F.ws + WS_K); const bf16* Vb = (const bf16*)(F.ws + WS_V); float* KV = (float*)(F.ws + WS_KV);
    for (int it = F.bid; it < NCH * RH; it += F.G) {
        const int n = it >> 3, h = it & 7; const float lg = ret_log_g(h);
        __syncthreads();
        for (int e = F.tid; e < 64 * 64; e += NTHREADS) { const int j = e >> 6, d = e & 63; Ks[e] = bf2f(Kb[(size_t)(n * 64 + j) * RQK + h * 64 + d]) * __expf((63.0f - (float)j) * lg); }
        for (int e = F.tid; e < 64 * 128; e += NTHREADS) { const int j = e >> 7, c = e & 127; Vs[e] = bf2f(Vb[(size_t)(n * 64 + j) * RW + h * 128 + c]); }
        __syncthreads();
        const int d = F.tid >> 3, e0 = (F.tid & 7) * 16;
        float a[16];
#pragma unroll
        for (int q = 0; q < 16; ++q) a[q] = 0.f;
#pragma unroll 2
        for (int j = 0; j < 64; ++j) { const float kd = Ks[j * 64 + d];
#pragma unroll
            for (int q = 0; q < 16; ++q) a[q] += kd * Vs[j * 128 + e0 + q]; }
        float* o = KV + ((size_t)it * 64 + d) * 128 + e0;
#pragma unroll
        for (int q = 0; q < 16; ++q) o[q] = a[q];
    }
}
__device__ __forceinline__ void scans_simple(Frame& F) {
    const int gt = F.bid * NTHREADS + F.tid;
    if (gt < RH * 64 * 128) {
        const int h = gt >> 13, de = gt & 8191; const float decay = __expf(64.0f * ret_log_g(h));
        float* p = (float*)(F.ws + WS_KV) + (size_t)h * 8192 + de; float st = 0.f;
        for (int n = 0; n < NCH; ++n) { const float kv = p[(size_t)n * 65536]; p[(size_t)n * 65536] = st; st = st * decay + kv; }
    } else if (gt < RH * 64 * 128 + S5G * S5P) {
        const int gp = gt - RH * 64 * 128; const f32x2 a = ((const f32x2*)(F.ws + WS_S5AB))[4096 + gp];
        f32x2* p = (f32x2*)(F.ws + WS_S5S) + gp; float xr = 0.f, xi = 0.f;
        bf16* xp = (bf16*)(F.ws + WS_XP) + (size_t)(gp >> 6) * 128 + (gp & 63);
        for (int c = 0; c < NCH; ++c) { const f32x2 s = p[(size_t)c * 4096]; xp[(size_t)c * 8192] = (bf16)f2bf(xr); xp[(size_t)c * 8192 + 64] = (bf16)f2bf(xi);
            const float nr = a.x * xr - a.y * xi + s.x, ni = a.x * xi + a.y * xr + s.y; xr = nr; xi = ni; }
    }
}
__device__ __forceinline__ void ret_out_simple(Frame& F) {
    LAS float* Qs = (LAS float*)F.lds;
    LAS float* Ks = Qs + 64 * 65;
    LAS float* Ss = Ks + 64 * 65;
    LAS float* Vs = Ss + 64 * 65;
    LAS float* Ps = Vs + 64 * 128;
    const bf16* Qb = (const bf16*)(F.ws + WS_Q); const bf16* Kb = (const bf16*)(F.ws + WS_K); const bf16* Vb = (const bf16*)(F.ws + WS_V);
    const float* KV = (const float*)(F.ws + WS_KV); const bf16* ZR = (const bf16*)(F.ws + WS_ZR); bf16* YR = (bf16*)(F.ws + WS_YR);
    for (int it = F.bid; it < NCH * RH; it += F.G) {
        const int n = it >> 3, h = it & 7; const float lg = ret_log_g(h);
        __syncthreads();
        for (int e = F.tid; e < 64 * 64; e += NTHREADS) { const int j = e >> 6, d = e & 63; const size_t g = (size_t)(n * 64 + j) * RQK + h * 64 + d; Qs[j * 65 + d] = bf2f(Qb[g]); Ks[j * 65 + d] = bf2f(Kb[g]); }
        for (int e = F.tid; e < 64 * 128; e += NTHREADS) { const int j = e >> 7, c = e & 127; Vs[e] = bf2f(Vb[(size_t)(n * 64 + j) * RW + h * 128 + c]); Ps[e] = KV[(size_t)it * 8192 + e]; }
        __syncthreads();
        const int i = F.tid >> 3, sub = F.tid & 7;
#pragma unroll
        for (int jj = 0; jj < 8; ++jj) { const int j = sub * 8 + jj; float s = 0.f;
#pragma unroll 4
            for (int d = 0; d < 64; ++d) s += Qs[i * 65 + d] * Ks[j * 65 + d];
            const float dist = fabsf((float)(i - j)); Ss[i * 65 + j] = s * __expf(dist * lg); }
        __syncthreads();
        const int e0 = sub * 16; float o[16], cr[16];
#pragma unroll
        for (int q = 0; q < 16; ++q) { o[q] = 0.f; cr[q] = 0.f; }
#pragma unroll 1
        for (int j = 0; j < 64; ++j) { const float s = Ss[i * 65 + j], qd = Qs[i * 65 + j];
#pragma unroll
            for (int q = 0; q < 16; ++q) { o[q] += s * Vs[j * 128 + e0 + q]; cr[q] += qd * Ps[j * 128 + e0 + q]; } }
        const float xi = __expf((float)(i + 1) * lg); float ss = 0.f;
#pragma unroll
        for (int q = 0; q < 16; ++q) { o[q] += xi * cr[q]; ss += o[q] * o[q]; }
        ss += __shfl_xor(ss, 1); ss += __shfl_xor(ss, 2); ss += __shfl_xor(ss, 4);
        const float r = 1.0f / sqrtf(ss * (1.0f / 128.0f) + EPS);
        const size_t g = (size_t)(n * 64 + i) * RW + h * 128 + e0;
#pragma unroll
        for (int q = 0; q < 16; ++q) YR[g + q] = (bf16)f2bf(o[q] * r * bf2f(ZR[g + q]));
    }
}
template <int MODE> __device__ __forceinline__ void s5_simple(Frame& F) {
    const int gw = F.bid * NWAVES + F.wave, NGW = F.G * NWAVES;
    const bf16* U = (const bf16*)(F.ws + WS_U); f32x2* S = (f32x2*)(F.ws + WS_S5S); bf16* Gg = (bf16*)(F.ws + WS_G);
    const f32x2* AB = (const f32x2*)(F.ws + WS_S5AB); const f32x2* BB = (const f32x2*)(F.ws + WS_S5BB);
    for (int it = gw; it < NCH * S5G; it += NGW) {
        const int c = it >> 6, g = it & 63, p = F.lane;
        const f32x2 a = AB[g * 64 + p];
        float bbr[16], bbi[16];
#pragma unroll
        for (int h = 0; h < 16; ++h) { const f32x2 b = BB[(size_t)(g * 64 + p) * 16 + h]; bbr[h] = b.x; bbi[h] = b.y; }
        float cre[16], cim[16], dsk = 0.f;
        if (MODE == 1) {
#pragma unroll
            for (int h = 0; h < 16; ++h) { cre[h] = F.in[8][(size_t)(g * 16 + h) * 64 + p]; cim[h] = F.in[9][(size_t)(g * 16 + h) * 64 + p]; }
            dsk = F.in[10][g * 16 + (p & 15)];
        }
        float xr = 0.f, xi = 0.f;
        if (MODE == 1) { const f32x2 x0 = S[(size_t)c * 4096 + g * 64 + p]; xr = x0.x; xi = x0.y; }
#pragma unroll 1
        for (int s = 0; s < 64; ++s) {
            const size_t t = (size_t)(c * 64 + s);
            const v4u u0 = *(const v4u*)(U + ((size_t)g * M + t) * 16), u1 = *(const v4u*)(U + ((size_t)g * M + t) * 16 + 8);
            float uu[16] = {bflo(u0.x), bfhi(u0.x), bflo(u0.y), bfhi(u0.y), bflo(u0.z), bfhi(u0.z), bflo(u0.w), bfhi(u0.w),
                            bflo(u1.x), bfhi(u1.x), bflo(u1.y), bfhi(u1.y), bflo(u1.z), bfhi(u1.z), bflo(u1.w), bfhi(u1.w)};
            float bur = 0.f, bui = 0.f;
#pragma unroll
            for (int h = 0; h < 16; ++h) { bur += bbr[h] * uu[h]; bui += bbi[h] * uu[h]; }
            const float nr = a.x * xr - a.y * xi + bur, ni = a.x * xi + a.y * xr + bui; xr = nr; xi = ni;
            if (MODE == 1) {
                float mine = 0.f;
#pragma unroll
                for (int h = 0; h < 16; ++h) { const float y = wave_sum(cre[h] * xr - cim[h] * xi); if ((p & 15) == h) mine = y + dsk * uu[h]; }
                if (p < 16) Gg[t * S5W + g * 16 + p] = (bf16)f2bf(gelu_tanh(mine));
            }
        }
        if (MODE == 0) S[(size_t)c * 4096 + g * 64 + p] = (f32x2){xr, xi};
    }
}

typedef short bf16x8 __attribute__((ext_vector_type(8)));
#define MFMA16(a, b, c) __builtin_amdgcn_mfma_f32_16x16x32_bf16(a, b, c, 0, 0, 0)
__device__ __forceinline__ void s5_pow(float lr, float li, float step, float m, float& zr, float& zi) {
    const float mag = __expf(lr * step * m);
    const double rev = (double)li * (double)step * (double)m * 0.15915494309189535;
    const float fr = (float)(rev - __builtin_rint(rev));
    zr = mag * __builtin_amdgcn_cosf(fr); zi = mag * __builtin_amdgcn_sinf(fr);
}
__device__ __forceinline__ void s5_zoh(float lr, float li, float step, float& fre, float& fim) {
    float abr, abi; s5_pow(lr, li, step, 1.0f, abr, abi);
    const float den = lr * lr + li * li, nr = abr - 1.0f;
    fre = (nr * lr + abi * li) / den; fim = (abi * lr - nr * li) / den;
}
__device__ __forceinline__ void p0_s5_tables(Frame& F) {
    LAS float* zs = (LAS float*)F.lds;
    LAS float* fs = zs + 256;
    LAS float* Bb = fs + 128;
    LAS float* Cz = Bb + 2048;
    bf16* TK = (bf16*)(F.ws + WS_TK);
    const float* lam_re = F.in[3]; const float* lam_im = F.in[4]; const float* lstep = F.in[5];
    for (int it = F.bid; it < 64 * 32; it += F.G) {
        const int g = it >> 5, lp = it & 31;
        __syncthreads();
        if (F.tid < 128) { const int sub = F.tid >> 6, p = F.tid & 63; const float lr = lam_re[g * 64 + p], li = lam_im[g * 64 + p], step = __expf(lstep[g]);
            float zr, zi; s5_pow(lr, li, step, (float)(2 * lp + sub), zr, zi); zs[(sub * 64 + p) * 2] = zr; zs[(sub * 64 + p) * 2 + 1] = zi;
            if (sub == 0) { float fre, fim; s5_zoh(lr, li, step, fre, fim); fs[2 * p] = fre; fs[2 * p + 1] = fim; } }
        __syncthreads();
        for (int e = F.tid; e < 1024; e += NTHREADS) { const int p = e >> 4; const float br = F.in[6][(size_t)g * 1024 + e], bi = F.in[7][(size_t)g * 1024 + e], fre = fs[2 * p], fim = fs[2 * p + 1];
            Bb[2 * e] = fre * br - fim * bi; Bb[2 * e + 1] = fre * bi + fim * br; }
        for (int e = F.tid; e < 2048; e += NTHREADS) { const int sub = e >> 10, hp = e & 1023, p = e & 63; const float cr = F.in[8][(size_t)g * 1024 + hp], ci = F.in[9][(size_t)g * 1024 + hp];
            const float zr = zs[(sub * 64 + p) * 2], zi = zs[(sub * 64 + p) * 2 + 1]; Cz[2 * e] = cr * zr - ci * zi; Cz[2 * e + 1] = cr * zi + ci * zr; }
        __syncthreads();
        { const int sub = F.tid >> 8, h = (F.tid >> 4) & 15, hp = F.tid & 15; float acc = 0.f;
            for (int p = 0; p < 64; ++p) acc += Cz[((sub * 16 + h) * 64 + p) * 2] * Bb[(p * 16 + hp) * 2] - Cz[((sub * 16 + h) * 64 + p) * 2 + 1] * Bb[(p * 16 + hp) * 2 + 1];
            TK[((size_t)g * 65 + (2 * lp + sub + 1)) * 256 + h * 16 + hp] = (bf16)f2bf(acc); }
        if (lp == 0 && F.tid < 256) TK[(size_t)g * 65 * 256 + F.tid] = 0;
    }
    __syncthreads();
    bf16* TV = (bf16*)(F.ws + WS_TV);
    const int gt = F.bid * NTHREADS + F.tid, NGT = F.G * NTHREADS;
    for (int e = gt; e < 64 * 64 * 64; e += NGT) {
        const int p = e & 63, tau = (e >> 6) & 63, g = e >> 12;
        float zr, zi; s5_pow(lam_re[g * 64 + p], lam_im[g * 64 + p], __expf(lstep[g]), (float)(tau + 1), zr, zi);
#pragma unroll
        for (int h = 0; h < 16; ++h) { const float cr = F.in[8][(size_t)(g * 16 + h) * 64 + p], ci = F.in[9][(size_t)(g * 16 + h) * 64 + p];
            bf16* o = TV + ((size_t)g * 1024 + tau * 16 + h) * 128 + p; o[0] = (bf16)f2bf(cr * zr - ci * zi); o[64] = (bf16)f2bf(-(cr * zi + ci * zr)); }
    }
}

template <int TB> __device__ __forceinline__ void s5_out_tb(Frame& F, int g, int rt, const LAS unsigned char* tk) {
    const int fr = F.lane & 15, fq = F.lane >> 4;
    const bf16* U = (const bf16*)(F.ws + WS_U); const bf16* XP = (const bf16*)(F.ws + WS_XP); const bf16* TV = (const bf16*)(F.ws + WS_TV) + (size_t)g * 1024 * 128;
    bf16* Gg = (bf16*)(F.ws + WS_G);
    const int c = 16 * rt + fr;
    const bf16* urow = U + ((size_t)g * M + 64 * c + (fq >> 1)) * 16 + 8 * (fq & 1);
    const int lbase = (1 - (fq >> 1)) * 512 + fr * 32 + (fq & 1) * 16;
    f32x4 acc[16];
#pragma unroll
    for (int q = 0; q < 16; ++q) acc[q] = (f32x4){0.f, 0.f, 0.f, 0.f};
    for (int ks = 0; ks < 8 * TB; ++ks) {
        const bf16x8 uf = *(const bf16x8*)(urow + ks * 32);
        const LAS unsigned char* tb = tk + lbase + (16 * TB - 2 * ks) * 512;
#pragma unroll
        for (int q = 0; q < 16; ++q) { const bf16x8 tf = *(const LAS bf16x8*)(tb + q * 512); acc[q] = MFMA16(tf, uf, acc[q]); }
    }
#pragma unroll
    for (int kq = 0; kq < 8; ++kq) {
        const bf16x8 uf = *(const bf16x8*)(urow + (8 * TB + kq) * 32);
#pragma unroll
        for (int q = 2 * kq; q < 16; ++q) { const bf16x8 tf = *(const LAS bf16x8*)(tk + lbase + (q - 2 * kq) * 512); acc[q] = MFMA16(tf, uf, acc[q]); }
        asm volatile("" ::: "memory");
    }
#pragma unroll
    for (int k2 = 0; k2 < 4; ++k2) {
        const bf16x8 xf = *(const bf16x8*)(XP + ((size_t)c * 64 + g) * 128 + 32 * k2 + 8 * fq);
#pragma unroll
        for (int q = 0; q < 16; ++q) { const bf16x8 vf = *(const bf16x8*)(TV + (size_t)((16 * TB + q) * 16 + fr) * 128 + 32 * k2 + 8 * fq); acc[q] = MFMA16(vf, xf, acc[q]);
            if ((q & 7) == 7) asm volatile("" ::: "memory"); }
    }
    const f32x4 d4 = *(const f32x4*)(F.in[10] + 16 * g + 4 * fq);
#pragma unroll
    for (int q = 0; q < 16; ++q) {
        const size_t tok = (size_t)64 * c + 16 * TB + q;
        const v2u uw = *(const v2u*)(U + ((size_t)g * M + tok) * 16 + 4 * fq);
        const float y0 = acc[q][0] + d4[0] * bflo(uw.x), y1 = acc[q][1] + d4[1] * bfhi(uw.x), y2 = acc[q][2] + d4[2] * bflo(uw.y), y3 = acc[q][3] + d4[3] * bfhi(uw.y);
        v2u w; w.x = pk2(gelu_tanh(y0), gelu_tanh(y1)); w.y = pk2(gelu_tanh(y2), gelu_tanh(y3));
        *(v2u*)(Gg + tok * S5W + 16 * g + 4 * fq) = w;
        if ((q & 3) == 3) asm volatile("" ::: "memory");
    }
}
__device__ __forceinline__ void s5_out_mfma(Frame& F) {
    for (int bi = F.bid; bi < 256; bi += F.G) {
        const int g = bi >> 2, idx = (bi & 3) * 8 + F.wave, rt = idx >> 1, pair = idx & 1;
        __syncthreads();
        { const v4u* src = (const v4u*)((const bf16*)(F.ws + WS_TK) + (size_t)g * 65 * 256); LAS v4u* dst = (LAS v4u*)F.lds;
            for (int e = F.tid; e < 65 * 512 / 16; e += NTHREADS) dst[e] = src[e]; }
        __syncthreads();
        if (pair == 0) { s5_out_tb<0>(F, g, rt, F.lds); s5_out_tb<3>(F, g, rt, F.lds); }
        else { s5_out_tb<1>(F, g, rt, F.lds); s5_out_tb<2>(F, g, rt, F.lds); }
    }
}

__device__ __forceinline__ void final_simple(Frame& F) {
    const int gw = F.bid * NWAVES + F.wave, NGW = F.G * NWAVES;
    const float* T = (const float*)(F.ws + WS_T); const float* x = F.in[0]; const float* gain = F.in[16];
    f32x4 gv[8];
#pragma unroll
    for (int j = 0; j < 8; ++j) gv[j] = *((const f32x4*)gain + F.lane + 64 * j);
    for (int m = gw; m < M; m += NGW) {
        const f32x4* tr = (const f32x4*)(T + (size_t)m * D) + F.lane; const f32x4* xr = (const f32x4*)(x + (size_t)m * D) + F.lane;
        f32x4 v[8]; float s = 0.f;
#pragma unroll
        for (int j = 0; j < 8; ++j) { v[j] = tr[64 * j]; s += (v[j].x * v[j].x + v[j].y * v[j].y) + (v[j].z * v[j].z + v[j].w * v[j].w); }
        const float r = 1.0f / sqrtf(wave_sum(s) * (1.0f / D) + EPS);
        f32x4* o = (f32x4*)(F.out + (size_t)m * D) + F.lane;
#pragma unroll
        for (int j = 0; j < 8; ++j) o[64 * j] = xr[64 * j] + v[j] * r * gv[j];
    }
}

struct Args { const float* in[17]; float* out; unsigned char* ws; int ph_lo, ph_hi; };
constexpr int NPHASES = 10;

__global__ void __launch_bounds__(NTHREADS, 2) fwd_kernel(Args args) {
    extern __shared__ __attribute__((aligned(16))) unsigned char lds_raw[];
    Frame F;
    F.lds = (LAS unsigned char*)lds_raw;
    F.tid = threadIdx.x; F.lane = F.tid & 63; F.wave = __builtin_amdgcn_readfirstlane(F.tid >> 6);
    F.G = gridDim.x; F.bid = blockIdx.x;
#pragma unroll
    for (int i = 0; i < 17; ++i) F.in[i] = args.in[i];
    F.out = args.out; F.ws = args.ws;
    const int lo = args.ph_lo, hi = args.ph_hi;
    cg::grid_group grid = cg::this_grid();
#ifndef PHMASK
#define PHMASK 0x3ff
#endif
#define IN(k) (((PHMASK >> (k)) & 1) && lo <= (k) && (k) < hi)
#define SEAM(k) do { if (IN(k) && IN((k) + 1)) grid.sync(); } while (0)
    using pg8::bf16_t;
    if (IN(0)) { p0_prologue(F); __syncthreads(); p0_s5_tables(F); } SEAM(0);
    if (IN(1)) {
        pg8::Gemm g{(const bf16_t*)(F.ws + WS_H), (const bf16_t*)(F.ws + WS_WIN), M, NIN, D}; pg8::StaticOrder S; S.init(M, NIN, F.G, F.bid);
        EpiIn E{F.ws};
        pg8::gemm_phase<EpiIn, pg8::StaticOrder, true, true>(F.lds, g, S, E);
    } SEAM(1);
    if (IN(2)) { ret_kv_simple(F); s5_simple<0>(F); } SEAM(2);
    if (IN(3)) { scans_simple(F); } SEAM(3);
    if (IN(4)) { ret_out_simple(F); s5_out_mfma(F); } SEAM(4);
    if (IN(5)) {
        pg8::Gemm g{(const bf16_t*)(F.ws + WS_G), (const bf16_t*)(F.ws + WS_WGLU), M, S5W, S5W}; pg8::StaticOrder S; S.init(M, S5W, F.G, F.bid);
        EpiGlu E{(const bf16*)(F.ws + WS_G), (const bf16*)(F.ws + WS_ZS), F.in[12], (bf16*)(F.ws + WS_YS)};
        pg8::gemm_phase<EpiGlu, pg8::StaticOrder, true, true>(F.lds, g, S, E);
    } SEAM(5);
    if (IN(6)) {
        pg8::Gemm g{(const bf16_t*)(F.ws + WS_YS), (const bf16_t*)(F.ws + WS_WS), M, D, S5W}; pg8::StaticOrder S; S.init(M, D, F.G, F.bid);
        EpiGate<false> E{(const bf16*)(F.ws + WS_GS), nullptr, (bf16*)(F.ws + WS_M1)};
        pg8::gemm_phase<EpiGate<false>, pg8::StaticOrder, true, true>(F.lds, g, S, E);
    } SEAM(6);
    if (IN(7)) {
        pg8::Gemm g{(const bf16_t*)(F.ws + WS_YR), (const bf16_t*)(F.ws + WS_WR), M, D, RW}; pg8::StaticOrder S; S.init(M, D, F.G, F.bid);
        EpiGate<true> E{(const bf16*)(F.ws + WS_GR), (const bf16*)(F.ws + WS_M1), (bf16*)(F.ws + WS_MM)};
        pg8::gemm_phase<EpiGate<true>, pg8::StaticOrder, true, true>(F.lds, g, S, E);
    } SEAM(7);
    if (IN(8)) {
        pg8::Gemm g{(const bf16_t*)(F.ws + WS_MM), (const bf16_t*)(F.ws + WS_WOUT), M, D, D}; pg8::StaticOrder S; S.init(M, D, F.G, F.bid);
        EpiF32P E{(float*)(F.ws + WS_T)};
        pg8::gemm_phase<EpiF32P, pg8::StaticOrder, true, true>(F.lds, g, S, E);
    } SEAM(8);
    if (IN(9)) { final_simple(F); }
#undef IN
#undef SEAM
}

#ifndef MK_PER_PHASE
#define MK_PER_PHASE 0
#endif
extern "C" void kernel_launch(void* const* d_in, const int* in_sizes, int n_in, void* d_out, int out_size, void* d_ws, size_t ws_size, hipStream_t stream) {
    static int grid = 0;
    if (grid == 0) {
        if (n_in != 17 || in_sizes[0] != M * D || out_size != M * D || ws_size < WS_END) { fprintf(stderr, "kernel_launch: unexpected shapes (n_in %d, in0 %d, out %d, ws %zu)\n", n_in, n_in > 0 ? in_sizes[0] : -1, out_size, ws_size); grid = -1; return; }
        int dev = 0, cus = 0, per_cu = 0;
        if (hipGetDevice(&dev) != hipSuccess || hipDeviceGetAttribute(&cus, hipDeviceAttributeMultiprocessorCount, dev) != hipSuccess) { grid = -1; return; }
        if (hipFuncSetAttribute((const void*)fwd_kernel, hipFuncAttributeMaxDynamicSharedMemorySize, LDS_BYTES) != hipSuccess) { fprintf(stderr, "kernel_launch: hipFuncSetAttribute failed\n"); grid = -1; return; }
        if (hipOccupancyMaxActiveBlocksPerMultiprocessor(&per_cu, (const void*)fwd_kernel, NTHREADS, LDS_BYTES) != hipSuccess || per_cu < 1) { fprintf(stderr, "kernel_launch: occupancy query says %d\n", per_cu); per_cu = 1; }
        (void)hipGetLastError();
        grid = cus;
    }
    if (grid < 0) return;
    Args a{};
    for (int i = 0; i < 17; ++i) a.in[i] = (const float*)d_in[i];
    a.out = (float*)d_out; a.ws = (unsigned char*)d_ws;
#if MK_PER_PHASE
    for (int p = 0; p < NPHASES; ++p) { a.ph_lo = p; a.ph_hi = p + 1; hipLaunchKernelGGL(fwd_kernel, dim3(grid), dim3(NTHREADS), LDS_BYTES, stream, a); }
#else
    a.ph_lo = 0; a.ph_hi = NPHASES;
    void* kargs[] = {&a};
    hipError_t e = hipLaunchCooperativeKernel((const void*)fwd_kernel, dim3(grid), dim3(NTHREADS), kargs, LDS_BYTES, stream);
    if (e != hipSuccess) fprintf(stderr, "kernel_launch: cooperative launch failed: %s (grid %d)\n", hipGetErrorString(e), grid);
#endif
}
```

```cpp
#include <hip/hip_runtime.h>
#include <cstdio>
#include <cstdint>
namespace pg8 {
#define PG8_LAS __attribute__((address_space(3)))
typedef unsigned short bf16_t;
typedef short bf16x8 __attribute__((ext_vector_type(8)));
typedef float f32x4 __attribute__((ext_vector_type(4)));
typedef unsigned u32x4 __attribute__((ext_vector_type(4)));
constexpr int BM = 256, BK = 64, HALF = 128, HTB = HALF * BK * 2  , STAGE_BYTES = 8 * HTB, NXCD = 8, WGM = 8;

__host__ __device__ __forceinline__ int lds_byte(int r, int c) { const int st = (r >> 4) * 2 + (c >> 5), rr = r & 15, cc = c & 31, ob = rr * 64 + cc * 2; return st * 1024 + (ob ^ (((ob >> 9) & 1) << 5)); }
__host__ __device__ __forceinline__ void stage_rc(int b, int& R, int& C) { const int st = b / 1024, sb = b % 1024, swz = sb ^ (((sb >> 9) & 1) << 5); R = (st >> 1) * 16 + swz / 64; C = (st & 1) * 32 + (swz % 64) / 2; }
__host__ __device__ __forceinline__ int perm32(int rho) { const int n = rho >> 4, i = rho & 15; return 8 * (i >> 2) + 4 * n + (i & 3); }

struct Unit { int pm, pn; };
struct Gemm { const bf16_t* A; const bf16_t* Bt; int M, N, K; };

struct StaticOrder {
    int nM, nN, nwg, G, c;
    __host__ __device__ void init(int M, int N, int G_, int c_) { nM = M / BM; nN = N / BM; nwg = nM * nN; G = G_; c = c_; }
    __host__ __device__ bool next(int i, Unit& u) const {
        const long L = (long)i * G + c; if (L >= nwg) return false;
        int wgid = (int)L; { const int q = nwg / NXCD, r = nwg % NXCD, xcd = wgid % NXCD, off = wgid / NXCD; wgid = (xcd < r ? xcd * (q + 1) : r * (q + 1) + (xcd - r) * q) + off; }
        const int nig = WGM * nN, gid = wgid / nig, fm = gid * WGM, gsz = (nM - fm) < WGM ? (nM - fm) : WGM;
        u.pm = fm + ((wgid % nig) % gsz); u.pn = (wgid % nig) / gsz; return true;
    }
    __device__ __forceinline__ void a_ready(const Unit&) const {}
    __device__ __forceinline__ void done(const Unit&) const {}
};

__device__ __forceinline__ unsigned cvt_pk_bf16(float lo, float hi) { unsigned r; asm volatile("v_cvt_pk_bf16_f32 %0, %1, %2" : "=v"(r) : "v"(lo), "v"(hi)); return r; }
typedef float f32x2 __attribute__((ext_vector_type(2)));
__device__ __forceinline__ f32x2 gelu_pk(f32x2 v) {
    const f32x2 av = __builtin_elementwise_abs(v), d = av * 0.2316418882f + 1.0f;
    f32x2 t; t.x = __builtin_amdgcn_rcpf(d.x); t.y = __builtin_amdgcn_rcpf(d.y);
    f32x2 q = t * 0.5307027145f + (-0.7265760135f); q = q * t + 0.7107068705f; q = q * t + (-0.142248368f); q = q * t + 0.127414796f; q = q * t;
    const f32x2 s = (v * v) * (-0.72134752044f);
    f32x2 e; e.x = __builtin_amdgcn_exp2f(s.x); e.y = __builtin_amdgcn_exp2f(s.y);
    const f32x2 m = v * (q * e), r = v - m;
    f32x2 o; o.x = v.x < 0.f ? m.x : r.x; o.y = v.y < 0.f ? m.y : r.y; return o;
}

template <int ACT  > struct EpiBf16 {
    static constexpr bool PERM = true, AFTER_DRAIN = false; static_assert(ACT == 0 || ACT == 1, "EpiBf16: ACT is 0 (none) or 1 (gelu_pk)");
    bf16_t* O; int ldc; const float* bias; int split_cols; size_t split_stride; float scale0;
    __device__ __forceinline__ void operator()(const f32x4 (&acc)[2][2][4][2], const Unit& u, int wr, int wc, int fr, int fq) const {
        const int row0 = u.pm * BM + wr * 64 + fr; int colt = u.pn * BM; bf16_t* base = O;
        float sc = 1.f; if (split_cols) { const int t = colt / split_cols; base += (size_t)t * split_stride; colt -= t * split_cols; if (t == 0) sc = scale0; }
        const int col0 = colt + wc * 32 + 8 * fq, bcol0 = u.pn * BM + wc * 32 + 8 * fq;
        f32x4 bv[2][2];
#pragma unroll
        for (int bj = 0; bj < 2; ++bj)
#pragma unroll
            for (int n = 0; n < 2; ++n) bv[bj][n] = bias ? *(const f32x4*)(bias + bcol0 + bj * HALF + 4 * n) : (f32x4){0.f, 0.f, 0.f, 0.f};
#pragma unroll
        for (int ai = 0; ai < 2; ++ai)
#pragma unroll
            for (int m = 0; m < 4; ++m) { bf16_t* rowp = base + (size_t)(row0 + ai * HALF + m * 16) * ldc + col0;
#pragma unroll
                for (int bj = 0; bj < 2; ++bj) { f32x4 v0 = acc[ai][bj][m][0] + bv[bj][0], v1 = acc[ai][bj][m][1] + bv[bj][1];
                    if (ACT == 1) { f32x2 a = gelu_pk((f32x2){v0[0], v0[1]}), b = gelu_pk((f32x2){v0[2], v0[3]}), c = gelu_pk((f32x2){v1[0], v1[1]}), d = gelu_pk((f32x2){v1[2], v1[3]});
                        v0 = (f32x4){a.x, a.y, b.x, b.y}; v1 = (f32x4){c.x, c.y, d.x, d.y}; }
                    v0 = v0 * sc; v1 = v1 * sc; u32x4 w; w.x = cvt_pk_bf16(v0[0], v0[1]); w.y = cvt_pk_bf16(v0[2], v0[3]); w.z = cvt_pk_bf16(v1[0], v1[1]); w.w = cvt_pk_bf16(v1[2], v1[3]);
                    *(u32x4*)(rowp + bj * HALF) = w; } }
    }
};

template <class Epi, class Sched, bool ALIGN_EPI = false, bool SP2 = false>
__device__ __forceinline__ void gemm_phase(PG8_LAS unsigned char* lds, const Gemm g, const Sched& S, const Epi& E) {
    const int tid = threadIdx.x, wid = __builtin_amdgcn_readfirstlane(tid >> 6), lane = tid & 63, wr = wid >> 2, wc = wid & 3, fr = lane & 15, fq = lane >> 4;
    const int K = g.K, nt = K / BK;
    unsigned voffA[2], voffB[2];
#pragma unroll
    for (int i = 0; i < 2; ++i) { int R, C; stage_rc(tid * 16 + i * 8192, R, C); const int Rb = Epi::PERM ? ((R & ~31) + perm32(R & 31)) : R;
        voffA[i] = (unsigned)(R * K + C) * 2u; voffB[i] = (unsigned)(Rb * K + C) * 2u; }
    const size_t kstep = (size_t)(BK * 2);
    const size_t hstep = (size_t)HALF * K * 2;
    const size_t tstep = 2 * hstep;
    const unsigned ldsw = (unsigned)wid * 1024u;
    const int aoff = lds_byte(wr * 64 + fr, fq * 8), boff = lds_byte(wc * 32 + fr, fq * 8);
#define PG8_SA(b, h) (((b) * 2 + (h)) * HTB)
#define PG8_SB(b, h) ((4 + (b) * 2 + (h)) * HTB)
#define PG8_STAGE(bufoff, gbase, voff) do { _Pragma("unroll") for (int _i = 0; _i < 2; ++_i) \
        __builtin_amdgcn_global_load_lds((const unsigned*)((const char*)(gbase) + (voff)[_i]), (PG8_LAS unsigned*)(lds + (bufoff) + ldsw + _i * 8192), 16, 0, 0); } while (0)
#define PG8_LDA(dst, b, h) do { _Pragma("unroll") for (int m = 0; m < 4; ++m) _Pragma("unroll") for (int k = 0; k < 2; ++k) dst[m][k] = *(const PG8_LAS bf16x8*)(lds + PG8_SA(b, h) + aoff + m * 2048 + k * 1024); } while (0)
#define PG8_LDB(dst, b, h) do { _Pragma("unroll") for (int n = 0; n < 2; ++n) _Pragma("unroll") for (int k = 0; k < 2; ++k) dst[n][k] = *(const PG8_LAS bf16x8*)(lds + PG8_SB(b, h) + boff + n * 2048 + k * 1024); } while (0)
#define PG8_MMA(ai, bj, At, Bt) do { __builtin_amdgcn_s_setprio(1); _Pragma("unroll") for (int m = 0; m < 4; ++m) _Pragma("unroll") for (int n = 0; n < 2; ++n) _Pragma("unroll") for (int k = 0; k < 2; ++k) \
        acc[ai][bj][m][n] = __builtin_amdgcn_mfma_f32_16x16x32_bf16(Bt[n][k], At[m][k], acc[ai][bj][m][n], 0, 0, 0); __builtin_amdgcn_s_setprio(0); } while (0)
#define PG8_WAIT_V(n) asm volatile("s_waitcnt vmcnt(" #n ")" ::: "memory")
#define PG8_WAIT_L(n) asm volatile("s_waitcnt lgkmcnt(" #n ")" ::: "memory")
#define PG8_BAR __builtin_amdgcn_s_barrier()
#define PG8_SCHED __builtin_amdgcn_sched_barrier(0)
    Unit cur, nxt; int ui = 0;
    if (!S.next(0, cur)) return;
    f32x4 acc[2][2][4][2];
#pragma unroll
    for (int a = 0; a < 2; ++a)
#pragma unroll
        for (int b = 0; b < 2; ++b)
#pragma unroll
            for (int m = 0; m < 4; ++m)
#pragma unroll
                for (int n = 0; n < 2; ++n) acc[a][b][m][n] = (f32x4){0.f, 0.f, 0.f, 0.f};
    bf16x8 At[4][2], B0[2][2], B1[2][2];
    const char* cA = (const char*)g.A + (size_t)cur.pm * tstep; const char* cB = (const char*)g.Bt + (size_t)cur.pn * tstep;
    S.a_ready(cur);
    if constexpr (SP2) {
        PG8_STAGE(PG8_SB(0, 0), cB, voffB); PG8_STAGE(PG8_SB(0, 1), cB + hstep, voffB); PG8_STAGE(PG8_SA(0, 0), cA, voffA); PG8_STAGE(PG8_SA(0, 1), cA + hstep, voffA);
        if (wr == 1) PG8_BAR;
        PG8_WAIT_V(2); PG8_BAR;
        PG8_STAGE(PG8_SB(1, 0), cB + kstep, voffB); PG8_STAGE(PG8_SA(1, 0), cA + kstep, voffA); PG8_STAGE(PG8_SB(1, 1), cB + hstep + kstep, voffB);
        PG8_WAIT_V(6); PG8_BAR;
    } else {
        PG8_STAGE(PG8_SB(0, 0), cB, voffB); PG8_STAGE(PG8_SA(0, 0), cA, voffA); PG8_STAGE(PG8_SB(0, 1), cB + hstep, voffB); PG8_STAGE(PG8_SA(0, 1), cA + hstep, voffA);
        if (wr == 1) PG8_BAR;
        PG8_WAIT_V(4); PG8_BAR;
        PG8_STAGE(PG8_SB(1, 0), cB + kstep, voffB); PG8_STAGE(PG8_SA(1, 0), cA + kstep, voffA); PG8_STAGE(PG8_SB(1, 1), cB + hstep + kstep, voffB);
        PG8_WAIT_V(6); PG8_BAR;
    }
    for (;;) {
        const bool has_next = S.next(ui + 1, nxt);
        const char* nA = has_next ? (const char*)g.A + (size_t)nxt.pm * tstep : cA; const char* nB = has_next ? (const char*)g.Bt + (size_t)nxt.pn * tstep : cB;
        for (int t = 0; t < nt; t += 2) {
            const bool last = (t == nt - 2);
            const char* a1 = cA + (size_t)(t + 1) * kstep;
            const char* a2 = last ? nA : cA + (size_t)(t + 2) * kstep; const char* b2 = last ? nB : cB + (size_t)(t + 2) * kstep;
            const char* a3 = a2 + kstep; const char* b3 = b2 + kstep;
            if (last && has_next) S.a_ready(nxt);
            if constexpr (SP2) {
            PG8_LDB(B0, 0, 0); PG8_LDB(B1, 0, 1); PG8_SCHED; PG8_LDA(At, 0, 0); PG8_STAGE(PG8_SA(1, 1), a1 + hstep, voffA);
            PG8_WAIT_V(8); PG8_WAIT_L(0); PG8_BAR; PG8_MMA(0, 0, At, B0); PG8_MMA(0, 1, At, B1); PG8_BAR; PG8_SCHED;
            PG8_LDA(At, 0, 1); PG8_STAGE(PG8_SB(0, 0), b2, voffB); PG8_STAGE(PG8_SB(0, 1), b2 + hstep, voffB); PG8_STAGE(PG8_SA(0, 0), a2, voffA);
            PG8_WAIT_V(8); PG8_WAIT_L(0); PG8_BAR; PG8_MMA(1, 0, At, B0); PG8_MMA(1, 1, At, B1); PG8_BAR; PG8_SCHED;
            PG8_LDB(B0, 1, 0); PG8_LDB(B1, 1, 1); PG8_SCHED; PG8_LDA(At, 1, 0); PG8_STAGE(PG8_SA(0, 1), a2 + hstep, voffA);
            PG8_WAIT_V(8); PG8_WAIT_L(0); PG8_BAR; PG8_MMA(0, 0, At, B0); PG8_MMA(0, 1, At, B1); PG8_BAR; PG8_SCHED;
            PG8_LDA(At, 1, 1); PG8_STAGE(PG8_SB(1, 0), b3, voffB); PG8_STAGE(PG8_SB(1, 1), b3 + hstep, voffB); PG8_STAGE(PG8_SA(1, 0), a3, voffA);
            PG8_WAIT_V(8); PG8_WAIT_L(0); PG8_BAR; PG8_MMA(1, 0, At, B0); PG8_MMA(1, 1, At, B1); PG8_BAR; PG8_SCHED;
            } else {
            PG8_LDB(B0, 0, 0); PG8_SCHED; PG8_LDA(At, 0, 0); PG8_STAGE(PG8_SA(1, 1), a1 + hstep, voffA);
            PG8_WAIT_L(8); PG8_BAR; PG8_WAIT_L(0); PG8_MMA(0, 0, At, B0); PG8_BAR; PG8_SCHED;
            PG8_LDB(B1, 0, 1); PG8_STAGE(PG8_SB(0, 0), b2, voffB);
            PG8_BAR; PG8_WAIT_L(0); PG8_MMA(0, 1, At, B1); PG8_BAR;
            PG8_LDA(At, 0, 1); PG8_STAGE(PG8_SA(0, 0), a2, voffA);
            PG8_BAR; PG8_WAIT_L(0); PG8_MMA(1, 0, At, B0); PG8_BAR; PG8_SCHED;
            PG8_STAGE(PG8_SB(0, 1), b2 + hstep, voffB);
            PG8_WAIT_V(6); PG8_BAR; PG8_MMA(1, 1, At, B1); PG8_BAR;
            PG8_LDB(B0, 1, 0); PG8_SCHED; PG8_LDA(At, 1, 0); PG8_STAGE(PG8_SA(0, 1), a2 + hstep, voffA);
            PG8_WAIT_L(8); PG8_BAR; PG8_WAIT_L(0); PG8_MMA(0, 0, At, B0); PG8_BAR; PG8_SCHED;
            PG8_LDB(B1, 1, 1); PG8_STAGE(PG8_SB(1, 0), b3, voffB);
            PG8_BAR; PG8_WAIT_L(0); PG8_MMA(0, 1, At, B1); PG8_BAR;
            PG8_LDA(At, 1, 1); PG8_STAGE(PG8_SA(1, 0), a3, voffA);
            PG8_BAR; PG8_WAIT_L(0); PG8_MMA(1, 0, At, B0); PG8_BAR; PG8_SCHED;
            PG8_STAGE(PG8_SB(1, 1), b3 + hstep, voffB);
            PG8_WAIT_V(6); PG8_BAR; PG8_MMA(1, 1, At, B1); PG8_BAR;
            }
        }
        if constexpr (ALIGN_EPI) { if (wr == 0) PG8_BAR; }
        if constexpr (!Epi::AFTER_DRAIN) { E(acc, cur, wr, wc, fr, fq); S.done(cur); }
        if (!has_next) break;
#pragma unroll
        for (int a = 0; a < 2; ++a)
#pragma unroll
            for (int b = 0; b < 2; ++b)
#pragma unroll
                for (int m = 0; m < 4; ++m)
#pragma unroll
                    for (int n = 0; n < 2; ++n) acc[a][b][m][n] = (f32x4){0.f, 0.f, 0.f, 0.f};
        cur = nxt; cA = nA; cB = nB; ++ui;
        if constexpr (ALIGN_EPI) { if (wr == 1) PG8_BAR; }
    }
    PG8_WAIT_V(0);
    if constexpr (!ALIGN_EPI) { if (wr == 0) PG8_BAR; }
    PG8_BAR;
    if constexpr (Epi::AFTER_DRAIN) { E.fused(acc, cur, wr, wc, fr, fq, lds, wid, lane); S.done(cur); }
#undef PG8_SA
#undef PG8_SB
#undef PG8_STAGE
#undef PG8_LDA
#undef PG8_LDB
#undef PG8_MMA
#undef PG8_WAIT_V
#undef PG8_WAIT_L
#undef PG8_BAR
#undef PG8_SCHED
}
}

#define GAS __attribute__((address_space(1)))
#define LAS __attribute__((address_space(3)))
typedef unsigned short bf16;
typedef unsigned v4u __attribute__((ext_vector_type(4)));
typedef unsigned v2u __attribute__((ext_vector_type(2)));
typedef float f32x4 __attribute__((ext_vector_type(4)));
typedef float f32x2 __attribute__((ext_vector_type(2)));

constexpr int NWAVES = 8, NTHREADS = 512;
constexpr int M = 16384, D = 2048, NIN = 9216;
constexpr int S5W = 1024, S5G = 64, S5H = 16, S5P = 64;
constexpr int RH = 8, RDK = 64, RDV = 128, RQK = 512, RW = 1024, CH = 64, NCH = M / CH;
constexpr float EPS = 1e-6f;

constexpr size_t MiB = 1u << 20;
constexpr size_t WS_CTL = 0;
constexpr size_t WS_WIN = 1 * MiB;
constexpr size_t WS_WGLU = 37 * MiB;
constexpr size_t WS_WS = 39 * MiB;
constexpr size_t WS_WR = 43 * MiB;
constexpr size_t WS_WOUT = 47 * MiB;
constexpr size_t WS_ROT = 55 * MiB;
constexpr size_t WS_S5AB = 59 * MiB;
constexpr size_t WS_S5BB = 59 * MiB + 65536;
constexpr size_t WS_H = 64 * MiB;
constexpr size_t WS_G = 64 * MiB, WS_YR = 96 * MiB;
constexpr size_t WS_U = 128 * MiB;
constexpr size_t WS_YS = 128 * MiB;
constexpr size_t WS_ZS = 160 * MiB;
constexpr size_t WS_Q = 192 * MiB;
constexpr size_t WS_K = 208 * MiB;
constexpr size_t WS_V = 224 * MiB;
constexpr size_t WS_M1 = 192 * MiB;
constexpr size_t WS_ZR = 256 * MiB;
constexpr size_t WS_GS = 288 * MiB;
constexpr size_t WS_GR = 352 * MiB;
constexpr size_t WS_KV = 416 * MiB;
constexpr size_t WS_MM = 416 * MiB;
constexpr size_t WS_S5S = 480 * MiB;
constexpr size_t WS_T = 160 * MiB;
constexpr size_t WS_TW = 432 * MiB;
constexpr size_t WS_TK = 60 * MiB;
constexpr size_t WS_TV = 488 * MiB;
constexpr size_t WS_XP = 504 * MiB;
constexpr size_t WS_END = 508 * MiB;

constexpr int LDS_BYTES = 147456;

__device__ __forceinline__ unsigned f2bf(float f) { unsigned u = __builtin_bit_cast(unsigned, f); return (u + 0x7fffu + ((u >> 16) & 1u)) >> 16; }
__device__ __forceinline__ unsigned pk2(float lo, float hi) { return f2bf(lo) | (f2bf(hi) << 16); }
__device__ __forceinline__ float bf2f(unsigned short b) { return __builtin_bit_cast(float, ((unsigned)b) << 16); }
__device__ __forceinline__ float bflo(unsigned w) { return __builtin_bit_cast(float, w << 16); }
__device__ __forceinline__ float bfhi(unsigned w) { return __builtin_bit_cast(float, w & 0xffff0000u); }
__device__ __forceinline__ float sigmoidf_(float z) { return __builtin_amdgcn_rcpf(1.0f + __expf(-z)); }
__device__ __forceinline__ float siluf_(float z) { return z * sigmoidf_(z); }
__device__ __forceinline__ float gelu_tanh(float x) {
    const float t = 1.5957691216057308f * (x + 0.044715f * x * x * x);
    return x * sigmoidf_(t);
}
__device__ __forceinline__ float wave_sum(float v) {
#pragma unroll
    for (int o = 1; o < 64; o <<= 1) v += __shfl_xor(v, o);
    return v;
}

#define XB_TMO      128
#define XB_XCNT(j)  (256  + 64 * (j))
#define XB_XSUB(j)  (1280 + 64 * (j))
#define XB_XGEN(j)  (2304 + 64 * (j))
#define XB_TOP      3328
#define XB_TOPGEN   3392
#define XCD_BAR_WORDS 3456
#define XB_SPIN_CAP (1u << 18)

__device__ __forceinline__ unsigned xb_ld(unsigned* p)              { return __hip_atomic_load(p, __ATOMIC_RELAXED, __HIP_MEMORY_SCOPE_AGENT); }
__device__ __forceinline__ unsigned xb_add(unsigned* p, unsigned v) { return __hip_atomic_fetch_add(p, v, __ATOMIC_RELAXED, __HIP_MEMORY_SCOPE_AGENT); }
__device__ __forceinline__ unsigned xb_xcc_id() { return (unsigned)__builtin_amdgcn_s_getreg((3 << 11) | 20) & 0xFu; }
#define XB_SPIN(cond, bar) do { unsigned _sp = 0; while (cond) { __builtin_amdgcn_s_sleep(1); \
    if ((++_sp & 255u) == 0u) { if (xb_ld(&(bar)[XB_TMO])) break; if (_sp > XB_SPIN_CAP) { atomicAdd(&(bar)[XB_TMO], 1u); break; } } } } while (0)

struct XcdBarrier {
    unsigned* bar; unsigned x;
    volatile LAS unsigned* st;
};

__device__ __forceinline__ XcdBarrier xcd_barrier_post(unsigned* bar, volatile LAS unsigned* st) {
    XcdBarrier b; b.bar = bar; b.x = xb_xcc_id(); b.st = st;
    if (threadIdx.x == 0) (void)xb_add(&bar[XB_XCNT(b.x)], 1u);
    return b;
}
__device__ __forceinline__ void xcd_barrier_complete(unsigned* bar, unsigned x, unsigned& nloc, unsigned& nx) {
    const unsigned G = gridDim.x * gridDim.y * gridDim.z;
    unsigned sum, cnt, mine, sp = 0u;
    for (;;) {
        sum = 0u; cnt = 0u; mine = 0u;
#pragma unroll
        for (unsigned j = 0; j < 16; ++j) { const unsigned c = xb_ld(&bar[XB_XCNT(j)]); sum += c; cnt += (c > 0u) ? 1u : 0u; mine = (j == x) ? c : mine; }
        if (sum == G) break;
        __builtin_amdgcn_s_sleep(1);
        if ((++sp & 255u) == 0u) { if (xb_ld(&bar[XB_TMO])) break; if (sp > XB_SPIN_CAP) { atomicAdd(&bar[XB_TMO], 1u); break; } }
    }
    nloc = mine > 0u ? mine : 1u; nx = cnt > 0u ? cnt : 1u;
}

__device__ __forceinline__ void xcd_barrier(const XcdBarrier& b) {
    asm volatile("s_waitcnt vmcnt(0)" ::: "memory");
    __syncthreads();
    if (threadIdx.x == 0) {
        unsigned* bar = b.bar;
        __builtin_amdgcn_s_waitcnt(0);
        unsigned nloc = b.st[0], nx = b.st[1];
        if (nloc == 0u) { xcd_barrier_complete(bar, b.x, nloc, nx); b.st[0] = nloc; b.st[1] = nx; }
        const unsigned old = xb_add(&bar[XB_XSUB(b.x)], 1u);
        const unsigned gen = old / nloc;
        if (old + 1u == (gen + 1u) * nloc) {
            __builtin_amdgcn_fence(__ATOMIC_RELEASE, "agent");
            asm volatile("s_waitcnt vmcnt(0)" ::: "memory");
            const unsigned og = xb_add(&bar[XB_TOP], 1u);
            const unsigned tg = og / nx;
            if (og + 1u == (tg + 1u) * nx) xb_add(&bar[XB_TOPGEN], 1u);
            else XB_SPIN(xb_ld(&bar[XB_TOPGEN]) == tg, bar);
            __builtin_amdgcn_fence(__ATOMIC_ACQUIRE, "agent");
            xb_add(&bar[XB_XGEN(b.x)], 1u);
            asm volatile("s_waitcnt vmcnt(0)" ::: "memory");
        } else {
            XB_SPIN(xb_ld(&bar[XB_XGEN(b.x)]) == gen, bar);
            __builtin_amdgcn_fence(__ATOMIC_ACQUIRE, "agent");
            asm volatile("s_waitcnt vmcnt(0)" ::: "memory");
        }
    }
    __syncthreads();
}

struct Frame {
    LAS unsigned char* lds;
    int tid, lane, wave, G, bid;
    const float* in[17];
    float* out;
    unsigned char* ws;
};

__device__ __forceinline__ void p0_transpose_item(const float* W, int K, int N, bf16* WT, int dest_row0, LAS float* scr, int k0, int n0, int lane) {
#pragma unroll 8
    for (int i = 0; i < 32; ++i) { const int kk = 2 * i + (lane >> 5); scr[kk * 33 + (lane & 31)] = W[(size_t)(k0 + kk) * N + n0 + (lane & 31)]; }
    asm volatile("s_waitcnt lgkmcnt(0)" ::: "memory");
    const int c = lane & 7;
#pragma unroll
    for (int j = 0; j < 4; ++j) { const int n = (lane >> 3) + 8 * j; const LAS float* s = scr + (8 * c) * 33 + n;
        v4u o; o.x = pk2(s[0 * 33], s[1 * 33]); o.y = pk2(s[2 * 33], s[3 * 33]); o.z = pk2(s[4 * 33], s[5 * 33]); o.w = pk2(s[6 * 33], s[7 * 33]);
        *(v4u*)(WT + (size_t)(dest_row0 + n) * K + k0 + 8 * c) = o; }
    asm volatile("s_waitcnt lgkmcnt(0)" ::: "memory");
}
__device__ __forceinline__ int win_dest_row(int n0) {
    if (n0 < 2048 || n0 >= 3072) return n0;
    const int w = n0 - 2048, T = w >> 8, r = w & 255, hh = r >> 6, s = (r >> 5) & 1;
    return 2048 + 256 * T + 128 * s + 32 * hh;
}
__device__ __forceinline__ void p0_prologue(Frame& F) {
    LAS float* scr = (LAS float*)(F.lds + F.wave * 16384);
    const int gw = F.bid * NWAVES + F.wave, NGW = F.G * NWAVES;
    bf16* WIN = (bf16*)(F.ws + WS_WIN); bf16* WGLU = (bf16*)(F.ws + WS_WGLU); bf16* WSs = (bf16*)(F.ws + WS_WS); bf16* WRr = (bf16*)(F.ws + WS_WR); bf16* WOUT = (bf16*)(F.ws + WS_WOUT);
    constexpr int I_IN = (D / 64) * (NIN / 32), I_GLU = (S5W / 64) * (S5W / 32), I_S = (S5W / 64) * (D / 32), I_R = (RW / 64) * (D / 32), I_OUT = (D / 64) * (D / 32);
    constexpr int NITEMS = I_IN + I_GLU + I_S + I_R + I_OUT;
    for (int it = gw; it < NITEMS; it += NGW) {
        int r = it;
        if (r < I_IN) { const int nb = NIN / 32, kb = r / nb, n0 = 32 * (r % nb); p0_transpose_item(F.in[2], D, NIN, WIN, win_dest_row(n0), scr, 64 * kb, n0, F.lane); continue; } r -= I_IN;
        if (r < I_GLU) { const int nb = S5W / 32, kb = r / nb, n0 = 32 * (r % nb); p0_transpose_item(F.in[11], S5W, S5W, WGLU, n0, scr, 64 * kb, n0, F.lane); continue; } r -= I_GLU;
        if (r < I_S) { const int nb = D / 32, kb = r / nb, n0 = 32 * (r % nb); p0_transpose_item(F.in[13], S5W, D, WSs, n0, scr, 64 * kb, n0, F.lane); continue; } r -= I_S;
        if (r < I_R) { const int nb = D / 32, kb = r / nb, n0 = 32 * (r % nb); p0_transpose_item(F.in[14], RW, D, WRr, n0, scr, 64 * kb, n0, F.lane); continue; } r -= I_R;
        { const int nb = D / 32, kb = r / nb, n0 = 32 * (r % nb); p0_transpose_item(F.in[15], D, D, WOUT, n0, scr, 64 * kb, n0, F.lane); }
    }
    {
        const float* x = F.in[0]; const float* gain = F.in[1]; bf16* H = (bf16*)(F.ws + WS_H);
        f32x4 gv[8];
#pragma unroll
        for (int j = 0; j < 8; ++j) gv[j] = *((const f32x4*)gain + F.lane + 64 * j);
        for (int m = gw; m < M; m += NGW) {
            const f32x4* xr = (const f32x4*)(x + (size_t)m * D) + F.lane;
            f32x4 v[8]; float s = 0.f;
#pragma unroll
            for (int j = 0; j < 8; ++j) { v[j] = xr[64 * j]; s += (v[j].x * v[j].x + v[j].y * v[j].y) + (v[j].z * v[j].z + v[j].w * v[j].w); }
            const float r = 1.0f / sqrtf(wave_sum(s) * (1.0f / D) + EPS);
            v2u* o8 = (v2u*)(H + (size_t)m * D) + F.lane;
#pragma unroll
            for (int j = 0; j < 8; ++j) { v2u w; w.x = pk2(v[j].x * r * gv[j].x, v[j].y * r * gv[j].y); w.y = pk2(v[j].z * r * gv[j].z, v[j].w * r * gv[j].w); o8[64 * j] = w; }
        }
    }
    {
        f32x2* rot = (f32x2*)(F.ws + WS_ROT);
        const int gt = F.bid * NTHREADS + F.tid, NGT = F.G * NTHREADS;
        for (int idx = gt; idx < M * 32; idx += NGT) {
            const int pos = idx >> 5, i = idx & 31;
            const float inv = exp2f(-(float)i * (13.287712379549449f / 32.0f));
            const float ang = (float)pos * inv;
            const double rev = (double)ang * 0.15915494309189535;
            const float fr = (float)(rev - __builtin_rint(rev));
            rot[idx] = (f32x2){__builtin_amdgcn_cosf(fr), __builtin_amdgcn_sinf(fr)};
        }
    }
    {
        const int gt = F.bid * NTHREADS + F.tid;
        if (gt < S5G * S5P) {
            const int g = gt >> 6;
            const float lr = F.in[3][gt], li = F.in[4][gt], step = __expf(F.in[5][g]);
            const float mag = __expf(lr * step), ang = li * step;
            const double rev = (double)ang * 0.15915494309189535;
            const float fr = (float)(rev - __builtin_rint(rev));
            const float abr = mag * __builtin_amdgcn_cosf(fr), abi = mag * __builtin_amdgcn_sinf(fr);
            const float den = lr * lr + li * li, nr = abr - 1.0f;
            const float fre = (nr * lr + abi * li) / den, fim = (abi * lr - nr * li) / den;
            f32x2* ab = (f32x2*)(F.ws + WS_S5AB);
            ab[gt] = (f32x2){abr, abi};
            float pr = abr, pi = abi;
#pragma unroll
            for (int q = 0; q < 6; ++q) { const float nr2 = pr * pr - pi * pi, ni2 = 2.0f * pr * pi; pr = nr2; pi = ni2; }
            ab[4096 + gt] = (f32x2){pr, pi};
            f32x2* bb = (f32x2*)(F.ws + WS_S5BB) + (size_t)gt * 16;
            const float* bre = F.in[6] + (size_t)gt * 16; const float* bim = F.in[7] + (size_t)gt * 16;
#pragma unroll
            for (int h = 0; h < 16; ++h) { const float br = bre[h], bi = bim[h]; bb[h] = (f32x2){fre * br - fim * bi, fre * bi + fim * br}; }
        }
    }
}

using pg8::Unit;
struct EpiIn {
    static constexpr bool PERM = true, AFTER_DRAIN = false;
    unsigned char* ws;
    __device__ __forceinline__ void operator()(const f32x4 (&acc)[2][2][4][2], const Unit& u, int wr, int wc, int fr, int fq) const {
        const int pn = u.pn, row0 = u.pm * 256 + wr * 64 + fr;
        if (pn >= 8 && pn < 12) {
            bf16* base = (bf16*)(ws + (pn < 10 ? WS_Q : WS_K)); const float sc0 = pn < 10 ? 1.0f : 0.125f;
            const float klg2 = pn < 10 ? 0.0f : -log1pf(-exp2f(-5.0f - (float)((pn & 1) * 4 + wc))) * 1.4426950408889634f;
            const int col0 = (pn & 1) * 256 + 64 * wc + 8 * fq;
            const f32x2* rot = (const f32x2*)(ws + WS_ROT);
#pragma unroll
            for (int ai = 0; ai < 2; ++ai)
#pragma unroll
                for (int m = 0; m < 4; ++m) {
                    const int row = row0 + ai * 128 + m * 16; const float sc = sc0 * exp2f((float)(16 * m + fr) * klg2);
                    const f32x4* rp = (const f32x4*)(rot + (size_t)row * 32 + 8 * fq);
                    const f32x4 r0 = rp[0], r1 = rp[1], r2 = rp[2], r3 = rp[3];
                    const float cs[8] = {r0.x, r0.z, r1.x, r1.z, r2.x, r2.z, r3.x, r3.z};
                    const float sn[8] = {r0.y, r0.w, r1.y, r1.w, r2.y, r2.w, r3.y, r3.w};
                    float o1[8], o2[8];
#pragma unroll
                    for (int n = 0; n < 2; ++n)
#pragma unroll
                        for (int j = 0; j < 4; ++j) { const float t1 = acc[ai][0][m][n][j], t2 = acc[ai][1][m][n][j], c = cs[4 * n + j], s = sn[4 * n + j];
                            o1[4 * n + j] = (t1 * c - t2 * s) * sc; o2[4 * n + j] = (t1 * s + t2 * c) * sc; }
                    bf16* rowp = base + (size_t)row * RQK + col0;
                    v4u w1, w2;
                    w1.x = pk2(o1[0], o1[1]); w1.y = pk2(o1[2], o1[3]); w1.z = pk2(o1[4], o1[5]); w1.w = pk2(o1[6], o1[7]);
                    w2.x = pk2(o2[0], o2[1]); w2.y = pk2(o2[2], o2[3]); w2.z = pk2(o2[4], o2[5]); w2.w = pk2(o2[6], o2[7]);
                    *(v4u*)rowp = w1; *(v4u*)(rowp + 32) = w2;
                }
            return;
        }
        if (pn < 4) {
            bf16* base = (bf16*)(ws + WS_U);
#pragma unroll
            for (int ai = 0; ai < 2; ++ai)
#pragma unroll
                for (int m = 0; m < 4; ++m) { const int row = row0 + ai * 128 + m * 16;
#pragma unroll
                    for (int bj = 0; bj < 2; ++bj) { const int col = pn * 256 + bj * 128 + wc * 32 + 8 * fq; const f32x4 v0 = acc[ai][bj][m][0], v1 = acc[ai][bj][m][1];
                        v4u w; w.x = pk2(v0[0], v0[1]); w.y = pk2(v0[2], v0[3]); w.z = pk2(v1[0], v1[1]); w.w = pk2(v1[2], v1[3]);
                        *(v4u*)(base + ((size_t)(col >> 4) * M + row) * 16 + (col & 8)) = w; } }
            return;
        }
        bf16* base; int ld, ct, act;
        if (pn < 8) { base = (bf16*)(ws + WS_ZS); ld = 1024; ct = pn - 4; act = 1; }
        else if (pn < 16) { base = (bf16*)(ws + WS_V); ld = 1024; ct = pn - 12; act = 0; }
        else if (pn < 20) { base = (bf16*)(ws + WS_ZR); ld = 1024; ct = pn - 16; act = 1; }
        else if (pn < 28) { base = (bf16*)(ws + WS_GS); ld = 2048; ct = pn - 20; act = 2; }
        else { base = (bf16*)(ws + WS_GR); ld = 2048; ct = pn - 28; act = 2; }
        const int col0 = ct * 256 + wc * 32 + 8 * fq;
#pragma unroll
        for (int ai = 0; ai < 2; ++ai)
#pragma unroll
            for (int m = 0; m < 4; ++m) { bf16* rowp = base + (size_t)(row0 + ai * 128 + m * 16) * ld + col0;
#pragma unroll
                for (int bj = 0; bj < 2; ++bj) { f32x4 v0 = acc[ai][bj][m][0], v1 = acc[ai][bj][m][1];
                    if (act == 1) {
#pragma unroll
                        for (int j = 0; j < 4; ++j) { v0[j] = siluf_(v0[j]); v1[j] = siluf_(v1[j]); } }
                    if (act == 2) {
#pragma unroll
                        for (int j = 0; j < 4; ++j) { v0[j] = sigmoidf_(v0[j]); v1[j] = sigmoidf_(v1[j]); } }
                    v4u w; w.x = pk2(v0[0], v0[1]); w.y = pk2(v0[2], v0[3]); w.z = pk2(v1[0], v1[1]); w.w = pk2(v1[2], v1[3]);
                    *(v4u*)(rowp + bj * 128) = w; } }
    }
};
struct EpiGlu {
    static constexpr bool PERM = true, AFTER_DRAIN = false;
    const bf16* G; const bf16* ZS; const float* bias; bf16* YS;
    __device__ __forceinline__ void operator()(const f32x4 (&acc)[2][2][4][2], const Unit& u, int wr, int wc, int fr, int fq) const {
        const int row0 = u.pm * 256 + wr * 64 + fr, col0 = u.pn * 256 + wc * 32 + 8 * fq;
#pragma unroll
        for (int ai = 0; ai < 2; ++ai)
#pragma unroll
            for (int m = 0; m < 4; ++m) { const size_t ro = (size_t)(row0 + ai * 128 + m * 16) * S5W + col0;
#pragma unroll
                for (int bj = 0; bj < 2; ++bj) {
                    const v4u gw = *(const v4u*)(G + ro + bj * 128), zw = *(const v4u*)(ZS + ro + bj * 128);
                    const f32x4 b0 = *(const f32x4*)(bias + col0 + bj * 128), b1 = *(const f32x4*)(bias + col0 + bj * 128 + 4);
                    const f32x4 v0 = acc[ai][bj][m][0] + b0, v1 = acc[ai][bj][m][1] + b1;
                    float o[8];
                    o[0] = bflo(gw.x) * sigmoidf_(v0[0]) * bflo(zw.x); o[1] = bfhi(gw.x) * sigmoidf_(v0[1]) * bfhi(zw.x);
                    o[2] = bflo(gw.y) * sigmoidf_(v0[2]) * bflo(zw.y); o[3] = bfhi(gw.y) * sigmoidf_(v0[3]) * bfhi(zw.y);
                    o[4] = bflo(gw.z) * sigmoidf_(v1[0]) * bflo(zw.z); o[5] = bfhi(gw.z) * sigmoidf_(v1[1]) * bfhi(zw.z);
                    o[6] = bflo(gw.w) * sigmoidf_(v1[2]) * bflo(zw.w); o[7] = bfhi(gw.w) * sigmoidf_(v1[3]) * bfhi(zw.w);
                    v4u w; w.x = pk2(o[0], o[1]); w.y = pk2(o[2], o[3]); w.z = pk2(o[4], o[5]); w.w = pk2(o[6], o[7]);
                    *(v4u*)(YS + ro + bj * 128) = w; } }
    }
};
template <bool ADD> struct EpiGate {
    static constexpr bool PERM = true, AFTER_DRAIN = false;
    const bf16* GATE; const bf16* PREV; bf16* O;
    __device__ __forceinline__ void operator()(const f32x4 (&acc)[2][2][4][2], const Unit& u, int wr, int wc, int fr, int fq) const {
        const int row0 = u.pm * 256 + wr * 64 + fr, col0 = u.pn * 256 + wc * 32 + 8 * fq;
#pragma unroll
        for (int ai = 0; ai < 2; ++ai)
#pragma unroll
            for (int m = 0; m < 4; ++m) { const size_t ro = (size_t)(row0 + ai * 128 + m * 16) * D + col0;
#pragma unroll
                for (int bj = 0; bj < 2; ++bj) {
                    const v4u gw = *(const v4u*)(GATE + ro + bj * 128);
                    const f32x4 v0 = acc[ai][bj][m][0], v1 = acc[ai][bj][m][1];
                    float o[8];
                    o[0] = bflo(gw.x) * v0[0]; o[1] = bfhi(gw.x) * v0[1]; o[2] = bflo(gw.y) * v0[2]; o[3] = bfhi(gw.y) * v0[3];
                    o[4] = bflo(gw.z) * v1[0]; o[5] = bfhi(gw.z) * v1[1]; o[6] = bflo(gw.w) * v1[2]; o[7] = bfhi(gw.w) * v1[3];
                    if (ADD) { const v4u pw = *(const v4u*)(PREV + ro + bj * 128);
                        o[0] += bflo(pw.x); o[1] += bfhi(pw.x); o[2] += bflo(pw.y); o[3] += bfhi(pw.y); o[4] += bflo(pw.z); o[5] += bfhi(pw.z); o[6] += bflo(pw.w); o[7] += bfhi(pw.w); }
                    v4u w; w.x = pk2(o[0], o[1]); w.y = pk2(o[2], o[3]); w.z = pk2(o[4], o[5]); w.w = pk2(o[6], o[7]);
                    *(v4u*)(O + ro + bj * 128) = w; } }
    }
};
struct EpiF32P {
    static constexpr bool PERM = true, AFTER_DRAIN = false;
    float* T;
    __device__ __forceinline__ void operator()(const f32x4 (&acc)[2][2][4][2], const Unit& u, int wr, int wc, int fr, int fq) const {
        const int row0 = u.pm * 256 + wr * 64 + fr, col0 = u.pn * 256 + wc * 32 + 8 * fq;
#pragma unroll
        for (int ai = 0; ai < 2; ++ai)
#pragma unroll
            for (int m = 0; m < 4; ++m) { float* rowp = T + (size_t)(row0 + ai * 128 + m * 16) * D + col0;
#pragma unroll
                for (int bj = 0; bj < 2; ++bj) { *(f32x4*)(rowp + bj * 128) = acc[ai][bj][m][0]; *(f32x4*)(rowp + bj * 128 + 4) = acc[ai][bj][m][1]; } }
    }
};

__device__ __forceinline__ float ret_log_g(int h) { return log1pf(-exp2f(-5.0f - (float)h)); }

__device__ __forceinline__ void ret_kv_simple(Frame& F) {
    LAS float* Ks = (LAS float*)F.lds;
    LAS float* Vs = Ks + 64 * 64;
    const bf16* Kb = (const bf16*)(F.ws + WS_K); const bf16* Vb = (const bf16*)(F.ws + WS_V); float* KV = (float*)(F.ws + WS_KV);
    for (int it = F.bid; it < NCH * RH; it += F.G) {
        const int n = it >> 3, h = it & 7; const float lg = ret_log_g(h);
        __syncthreads();
        for (int e = F.tid; e < 64 * 64; e += NTHREADS) { const int j = e >> 6, d = e & 63; Ks[e] = bf2f(Kb[(size_t)(n * 64 + j) * RQK + h * 64 + d]) * __expf((63.0f - (float)j) * lg); }
        for (int e = F.tid; e < 64 * 128; e += NTHREADS) { const int j = e >> 7, c = e & 127; Vs[e] = bf2f(Vb[(size_t)(n * 64 + j) * RW + h * 128 + c]); }
        __syncthreads();
        const int d = F.tid >> 3, e0 = (F.tid & 7) * 16;
        float a[16];
#pragma unroll
        for (int q = 0; q < 16; ++q) a[q] = 0.f;
#pragma unroll 2
        for (int j = 0; j < 64; ++j) { const float kd = Ks[j * 64 + d];
#pragma unroll
            for (int q = 0; q < 16; ++q) a[q] += kd * Vs[j * 128 + e0 + q]; }
        float* o = KV + ((size_t)it * 64 + d) * 128 + e0;
#pragma unroll
        for (int q = 0; q < 16; ++q) o[q] = a[q];
    }
}
__device__ __forceinline__ void scans_simple(Frame& F) {
    const int gt = F.bid * NTHREADS + F.tid;
    if (gt < RH * 64 * 128) {
    } else if (gt < RH * 64 * 128 + S5G * S5P) {
        const int gp = gt - RH * 64 * 128; const f32x2 a = ((const f32x2*)(F.ws + WS_S5AB))[4096 + gp];
        f32x2* p = (f32x2*)(F.ws + WS_S5S) + gp; float xr = 0.f, xi = 0.f;
        bf16* xp = (bf16*)(F.ws + WS_XP) + (size_t)(gp >> 6) * 128 + (gp & 63);
        for (int c = 0; c < NCH; ++c) { const f32x2 s = p[(size_t)c * 4096]; xp[(size_t)c * 8192] = (bf16)f2bf(xr); xp[(size_t)c * 8192 + 64] = (bf16)f2bf(xi);
            const float nr = a.x * xr - a.y * xi + s.x, ni = a.x * xi + a.y * xr + s.y; xr = nr; xi = ni; }
    }
}
__device__ __forceinline__ void ret_out_simple(Frame& F) {
    LAS float* Qs = (LAS float*)F.lds;
    LAS float* Ks = Qs + 64 * 65;
    LAS float* Ss = Ks + 64 * 65;
    LAS float* Vs = Ss + 64 * 65;
    LAS float* Ps = Vs + 64 * 128;
    const bf16* Qb = (const bf16*)(F.ws + WS_Q); const bf16* Kb = (const bf16*)(F.ws + WS_K); const bf16* Vb = (const bf16*)(F.ws + WS_V);
    const float* KV = (const float*)(F.ws + WS_KV); const bf16* ZR = (const bf16*)(F.ws + WS_ZR); bf16* YR = (bf16*)(F.ws + WS_YR);
    for (int it = F.bid; it < NCH * RH; it += F.G) {
        const int n = it >> 3, h = it & 7; const float lg = ret_log_g(h);
        __syncthreads();
        for (int e = F.tid; e < 64 * 64; e += NTHREADS) { const int j = e >> 6, d = e & 63; const size_t g = (size_t)(n * 64 + j) * RQK + h * 64 + d; Qs[j * 65 + d] = bf2f(Qb[g]); Ks[j * 65 + d] = bf2f(Kb[g]); }
        for (int e = F.tid; e < 64 * 128; e += NTHREADS) { const int j = e >> 7, c = e & 127; Vs[e] = bf2f(Vb[(size_t)(n * 64 + j) * RW + h * 128 + c]); Ps[e] = KV[(size_t)it * 8192 + e]; }
        __syncthreads();
        const int i = F.tid >> 3, sub = F.tid & 7;
#pragma unroll
        for (int jj = 0; jj < 8; ++jj) { const int j = sub * 8 + jj; float s = 0.f;
#pragma unroll 4
            for (int d = 0; d < 64; ++d) s += Qs[i * 65 + d] * Ks[j * 65 + d];
            const float dist = fabsf((float)(i - j)); Ss[i * 65 + j] = s * __expf(dist * lg); }
        __syncthreads();
        const int e0 = sub * 16; float o[16], cr[16];
#pragma unroll
        for (int q = 0; q < 16; ++q) { o[q] = 0.f; cr[q] = 0.f; }
#pragma unroll 1
        for (int j = 0; j < 64; ++j) { const float s = Ss[i * 65 + j], qd = Qs[i * 65 + j];
#pragma unroll
            for (int q = 0; q < 16; ++q) { o[q] += s * Vs[j * 128 + e0 + q]; cr[q] += qd * Ps[j * 128 + e0 + q]; } }
        const float xi = __expf((float)(i + 1) * lg); float ss = 0.f;
#pragma unroll
        for (int q = 0; q < 16; ++q) { o[q] += xi * cr[q]; ss += o[q] * o[q]; }
        ss += __shfl_xor(ss, 1); ss += __shfl_xor(ss, 2); ss += __shfl_xor(ss, 4);
        const float r = 1.0f / sqrtf(ss * (1.0f / 128.0f) + EPS);
        const size_t g = (size_t)(n * 64 + i) * RW + h * 128 + e0;
#pragma unroll
        for (int q = 0; q < 16; ++q) YR[g + q] = (bf16)f2bf(o[q] * r * bf2f(ZR[g + q]));
    }
}
template <int MODE> __device__ __forceinline__ void s5_simple(Frame& F) {
    const int gw = F.bid * NWAVES + F.wave, NGW = F.G * NWAVES;
    const bf16* U = (const bf16*)(F.ws + WS_U); f32x2* S = (f32x2*)(F.ws + WS_S5S); bf16* Gg = (bf16*)(F.ws + WS_G);
    const f32x2* AB = (const f32x2*)(F.ws + WS_S5AB); const f32x2* BB = (const f32x2*)(F.ws + WS_S5BB);
    for (int it = gw; it < NCH * S5G; it += NGW) {
        const int c = it >> 6, g = it & 63, p = F.lane;
        const f32x2 a = AB[g * 64 + p];
        float bbr[16], bbi[16];
#pragma unroll
        for (int h = 0; h < 16; ++h) { const f32x2 b = BB[(size_t)(g * 64 + p) * 16 + h]; bbr[h] = b.x; bbi[h] = b.y; }
        float cre[16], cim[16], dsk = 0.f;
        if (MODE == 1) {
#pragma unroll
            for (int h = 0; h < 16; ++h) { cre[h] = F.in[8][(size_t)(g * 16 + h) * 64 + p]; cim[h] = F.in[9][(size_t)(g * 16 + h) * 64 + p]; }
            dsk = F.in[10][g * 16 + (p & 15)];
        }
        float xr = 0.f, xi = 0.f;
        if (MODE == 1) { const f32x2 x0 = S[(size_t)c * 4096 + g * 64 + p]; xr = x0.x; xi = x0.y; }
#pragma unroll 1
        for (int s = 0; s < 64; ++s) {
            const size_t t = (size_t)(c * 64 + s);
            const v4u u0 = *(const v4u*)(U + ((size_t)g * M + t) * 16), u1 = *(const v4u*)(U + ((size_t)g * M + t) * 16 + 8);
            float uu[16] = {bflo(u0.x), bfhi(u0.x), bflo(u0.y), bfhi(u0.y), bflo(u0.z), bfhi(u0.z), bflo(u0.w), bfhi(u0.w),
                            bflo(u1.x), bfhi(u1.x), bflo(u1.y), bfhi(u1.y), bflo(u1.z), bfhi(u1.z), bflo(u1.w), bfhi(u1.w)};
            float bur = 0.f, bui = 0.f;
#pragma unroll
            for (int h = 0; h < 16; ++h) { bur += bbr[h] * uu[h]; bui += bbi[h] * uu[h]; }
            const float nr = a.x * xr - a.y * xi + bur, ni = a.x * xi + a.y * xr + bui; xr = nr; xi = ni;
            if (MODE == 1) {
                float mine = 0.f;
#pragma unroll
                for (int h = 0; h < 16; ++h) { const float y = wave_sum(cre[h] * xr - cim[h] * xi); if ((p & 15) == h) mine = y + dsk * uu[h]; }
                if (p < 16) Gg[t * S5W + g * 16 + p] = (bf16)f2bf(gelu_tanh(mine));
            }
        }
        if (MODE == 0) S[(size_t)c * 4096 + g * 64 + p] = (f32x2){xr, xi};
    }
}

typedef short bf16x8 __attribute__((ext_vector_type(8)));
#define MFMA16(a, b, c) __builtin_amdgcn_mfma_f32_16x16x32_bf16(a, b, c, 0, 0, 0)
__device__ __forceinline__ void s5_pow(float lr, float li, float step, float m, float& zr, float& zi) {
    const float mag = __expf(lr * step * m);
    const double rev = (double)li * (double)step * (double)m * 0.15915494309189535;
    const float fr = (float)(rev - __builtin_rint(rev));
    zr = mag * __builtin_amdgcn_cosf(fr); zi = mag * __builtin_amdgcn_sinf(fr);
}
__device__ __forceinline__ void s5_zoh(float lr, float li, float step, float& fre, float& fim) {
    float abr, abi; s5_pow(lr, li, step, 1.0f, abr, abi);
    const float den = lr * lr + li * li, nr = abr - 1.0f;
    fre = (nr * lr + abi * li) / den; fim = (abi * lr - nr * li) / den;
}
__device__ __forceinline__ void p0_s5_tables(Frame& F) {
    LAS float* zs = (LAS float*)F.lds;
    LAS float* fs = zs + 256;
    LAS float* Bb = fs + 128;
    LAS float* Cz = Bb + 2048;
    bf16* TK = (bf16*)(F.ws + WS_TK);
    const float* lam_re = F.in[3]; const float* lam_im = F.in[4]; const float* lstep = F.in[5];
    for (int it = F.bid; it < 64 * 32; it += F.G) {
        const int g = it >> 5, lp = it & 31;
        __syncthreads();
        if (F.tid < 128) { const int sub = F.tid >> 6, p = F.tid & 63; const float lr = lam_re[g * 64 + p], li = lam_im[g * 64 + p], step = __expf(lstep[g]);
            float zr, zi; s5_pow(lr, li, step, (float)(2 * lp + sub), zr, zi); zs[(sub * 64 + p) * 2] = zr; zs[(sub * 64 + p) * 2 + 1] = zi;
            if (sub == 0) { float fre, fim; s5_zoh(lr, li, step, fre, fim); fs[2 * p] = fre; fs[2 * p + 1] = fim; } }
        __syncthreads();
        for (int e = F.tid; e < 1024; e += NTHREADS) { const int p = e >> 4; const float br = F.in[6][(size_t)g * 1024 + e], bi = F.in[7][(size_t)g * 1024 + e], fre = fs[2 * p], fim = fs[2 * p + 1];
            Bb[2 * e] = fre * br - fim * bi; Bb[2 * e + 1] = fre * bi + fim * br; }
        for (int e = F.tid; e < 2048; e += NTHREADS) { const int sub = e >> 10, hp = e & 1023, p = e & 63; const float cr = F.in[8][(size_t)g * 1024 + hp], ci = F.in[9][(size_t)g * 1024 + hp];
            const float zr = zs[(sub * 64 + p) * 2], zi = zs[(sub * 64 + p) * 2 + 1]; Cz[2 * e] = cr * zr - ci * zi; Cz[2 * e + 1] = cr * zi + ci * zr; }
        __syncthreads();
        { const int sub = F.tid >> 8, h = (F.tid >> 4) & 15, hp = F.tid & 15; float acc = 0.f;
            for (int p = 0; p < 64; ++p) acc += Cz[((sub * 16 + h) * 64 + p) * 2] * Bb[(p * 16 + hp) * 2] - Cz[((sub * 16 + h) * 64 + p) * 2 + 1] * Bb[(p * 16 + hp) * 2 + 1];
            TK[((size_t)g * 65 + (2 * lp + sub + 1)) * 256 + h * 16 + hp] = (bf16)f2bf(acc); }
        if (lp == 0 && F.tid < 256) TK[(size_t)g * 65 * 256 + F.tid] = 0;
    }
    __syncthreads();
    bf16* TV = (bf16*)(F.ws + WS_TV);
    const int gt = F.bid * NTHREADS + F.tid, NGT = F.G * NTHREADS;
    for (int e = gt; e < 64 * 64 * 64; e += NGT) {
        const int p = e & 63, tau = (e >> 6) & 63, g = e >> 12;
        float zr, zi; s5_pow(lam_re[g * 64 + p], lam_im[g * 64 + p], __expf(lstep[g]), (float)(tau + 1), zr, zi);
#pragma unroll
        for (int h = 0; h < 16; ++h) { const float cr = F.in[8][(size_t)(g * 16 + h) * 64 + p], ci = F.in[9][(size_t)(g * 16 + h) * 64 + p];
            bf16* o = TV + ((size_t)g * 1024 + tau * 16 + h) * 128 + p; o[0] = (bf16)f2bf(cr * zr - ci * zi); o[64] = (bf16)f2bf(-(cr * zi + ci * zr)); }
    }
    bf16* TW = (bf16*)(F.ws + WS_TW);
    for (int e = gt; e < 64 * 64 * 64; e += NGT) {
        const int sidx = e & 63, p = (e >> 6) & 63, g = e >> 12;
        const float lr = lam_re[g * 64 + p], li = lam_im[g * 64 + p], step = __expf(lstep[g]);
        float zr, zi, fre, fim; s5_pow(lr, li, step, (float)(63 - sidx), zr, zi); s5_zoh(lr, li, step, fre, fim);
        const float wr = zr * fre - zi * fim, wi = zr * fim + zi * fre;
        const f32x4* bre = (const f32x4*)(F.in[6] + (size_t)(g * 64 + p) * 16); const f32x4* bim = (const f32x4*)(F.in[7] + (size_t)(g * 64 + p) * 16);
        v4u ore[2], oim[2];
#pragma unroll
        for (int q = 0; q < 2; ++q) { const f32x4 r0 = bre[2 * q], r1 = bre[2 * q + 1], i0 = bim[2 * q], i1 = bim[2 * q + 1];
            ore[q].x = pk2(wr * r0.x - wi * i0.x, wr * r0.y - wi * i0.y); ore[q].y = pk2(wr * r0.z - wi * i0.z, wr * r0.w - wi * i0.w);
            ore[q].z = pk2(wr * r1.x - wi * i1.x, wr * r1.y - wi * i1.y); ore[q].w = pk2(wr * r1.z - wi * i1.z, wr * r1.w - wi * i1.w);
            oim[q].x = pk2(wr * i0.x + wi * r0.x, wr * i0.y + wi * r0.y); oim[q].y = pk2(wr * i0.z + wi * r0.z, wr * i0.w + wi * r0.w);
            oim[q].z = pk2(wr * i1.x + wi * r1.x, wr * i1.y + wi * r1.y); oim[q].w = pk2(wr * i1.z + wi * r1.z, wr * i1.w + wi * r1.w); }
        v4u* o0 = (v4u*)(TW + ((size_t)g * 128 + p) * 1024 + sidx * 16); v4u* o1 = (v4u*)(TW + ((size_t)g * 128 + 64 + p) * 1024 + sidx * 16);
        o0[0] = ore[0]; o0[1] = ore[1]; o1[0] = oim[0]; o1[1] = oim[1];
    }
}

template <int TB> __device__ __forceinline__ void s5_out_tb(Frame& F, int g, int rt, const LAS unsigned char* tk) {
    const int fr = F.lane & 15, fq = F.lane >> 4;
    const bf16* U = (const bf16*)(F.ws + WS_U); const bf16* XP = (const bf16*)(F.ws + WS_XP); const bf16* TV = (const bf16*)(F.ws + WS_TV) + (size_t)g * 1024 * 128;
    bf16* Gg = (bf16*)(F.ws + WS_G);
    const int c = 16 * rt + fr;
    const bf16* urow = U + ((size_t)g * M + 64 * c + (fq >> 1)) * 16 + 8 * (fq & 1);
    const int lbase = (1 - (fq >> 1)) * 512 + fr * 32 + (fq & 1) * 16;
    f32x4 acc[16];
#pragma unroll
    for (int q = 0; q < 16; ++q) acc[q] = (f32x4){0.f, 0.f, 0.f, 0.f};
    for (int ks = 0; ks < 8 * TB; ++ks) {
        const bf16x8 uf = *(const bf16x8*)(urow + ks * 32);
        const LAS unsigned char* tb = tk + lbase + (16 * TB - 2 * ks) * 512;
#pragma unroll
        for (int q = 0; q < 16; ++q) { const bf16x8 tf = *(const LAS bf16x8*)(tb + q * 512); acc[q] = MFMA16(tf, uf, acc[q]); if ((q & 7) == 7) asm volatile("" ::: "memory"); }
    }
#pragma unroll
    for (int kq = 0; kq < 8; ++kq) {
        const bf16x8 uf = *(const bf16x8*)(urow + (8 * TB + kq) * 32);
#pragma unroll
        for (int q = 2 * kq; q < 16; ++q) { const bf16x8 tf = *(const LAS bf16x8*)(tk + lbase + (q - 2 * kq) * 512); acc[q] = MFMA16(tf, uf, acc[q]); }
        asm volatile("" ::: "memory");
    }
#pragma unroll
    for (int k2 = 0; k2 < 4; ++k2) {
        const bf16x8 xf = *(const bf16x8*)(XP + ((size_t)c * 64 + g) * 128 + 32 * k2 + 8 * fq);
#pragma unroll
        for (int q = 0; q < 16; ++q) { const bf16x8 vf = *(const bf16x8*)(TV + (size_t)((16 * TB + q) * 16 + fr) * 128 + 32 * k2 + 8 * fq); acc[q] = MFMA16(vf, xf, acc[q]);
            if ((q & 7) == 7) asm volatile("" ::: "memory"); }
    }
    const f32x4 d4 = *(const f32x4*)(F.in[10] + 16 * g + 4 * fq);
#pragma unroll
    for (int q = 0; q < 16; ++q) {
        const size_t tok = (size_t)64 * c + 16 * TB + q;
        const v2u uw = *(const v2u*)(U + ((size_t)g * M + tok) * 16 + 4 * fq);
        const float y0 = acc[q][0] + d4[0] * bflo(uw.x), y1 = acc[q][1] + d4[1] * bfhi(uw.x), y2 = acc[q][2] + d4[2] * bflo(uw.y), y3 = acc[q][3] + d4[3] * bfhi(uw.y);
        v2u w; w.x = pk2(gelu_tanh(y0), gelu_tanh(y1)); w.y = pk2(gelu_tanh(y2), gelu_tanh(y3));
        *(v2u*)(Gg + tok * S5W + 16 * g + 4 * fq) = w;
        if ((q & 3) == 3) asm volatile("" ::: "memory");
    }
}
__device__ __forceinline__ void s5_out_mfma(Frame& F) {
    for (int bi = F.bid; bi < 256; bi += F.G) {
        const int g = bi >> 2, idx = (bi & 3) * 8 + F.wave, rt = idx >> 1, pair = idx & 1;
        __syncthreads();
        { const v4u* src = (const v4u*)((const bf16*)(F.ws + WS_TK) + (size_t)g * 65 * 256); LAS v4u* dst = (LAS v4u*)F.lds;
            for (int e = F.tid; e < 65 * 512 / 16; e += NTHREADS) dst[e] = src[e]; }
        __syncthreads();
        if (pair == 0) { s5_out_tb<0>(F, g, rt, F.lds); s5_out_tb<3>(F, g, rt, F.lds); }
        else { s5_out_tb<1>(F, g, rt, F.lds); s5_out_tb<2>(F, g, rt, F.lds); }
    }
}


typedef short v4i16_t __attribute__((ext_vector_type(4)));
constexpr int RKT_STRIDE = 144, RVT_STRIDE = 80, RWAVE_LDS = 64 * RKT_STRIDE + 64 * RVT_STRIDE;
constexpr int RUN = 4, NRUN = NCH / RUN;
__device__ __forceinline__ float ret_lg2(int h) { return log1pf(-exp2f(-5.0f - (float)h)) * 1.4426950408889634f; }
__device__ __forceinline__ bf16x8 tr8(const LAS unsigned char* p0, const LAS unsigned char* p1) {
    const v4i16_t lo = __builtin_amdgcn_ds_read_tr16_b64_v4i16((LAS v4i16_t*)p0), hi = __builtin_amdgcn_ds_read_tr16_b64_v4i16((LAS v4i16_t*)p1);
    return (bf16x8){lo[0], lo[1], lo[2], lo[3], hi[0], hi[1], hi[2], hi[3]};
}
__device__ __forceinline__ bf16x8 pack8(const f32x4 a, const f32x4 b) {
    v4u w; w.x = pk2(a[0], a[1]); w.y = pk2(a[2], a[3]); w.z = pk2(b[0], b[1]); w.w = pk2(b[2], b[3]); return __builtin_bit_cast(bf16x8, w);
}
__device__ __forceinline__ void ret_stage(Frame& F, LAS unsigned char* kt, LAS unsigned char* vt, int n, int h, int eq) {
    const bf16* Kb = (const bf16*)(F.ws + WS_K) + (size_t)n * 64 * RQK + h * 64; const bf16* Vb = (const bf16*)(F.ws + WS_V) + (size_t)n * 64 * RW + h * 128 + eq * 32;
    const int kl = (F.lane >> 3) * RQK + (F.lane & 7) * 8, vl = (F.lane >> 2) * RW + (F.lane & 3) * 8;
    v4u kr[8], vr[4];
#pragma unroll
    for (int i = 0; i < 8; ++i) kr[i] = *(const v4u*)((Kb + (size_t)i * 8 * RQK) + kl);
#pragma unroll
    for (int i = 0; i < 4; ++i) vr[i] = *(const v4u*)((Vb + (size_t)i * 16 * RW) + vl);
    LAS unsigned char* kw = kt + (F.lane >> 3) * RKT_STRIDE + (F.lane & 7) * 16; LAS unsigned char* vw = vt + (F.lane >> 2) * RVT_STRIDE + (F.lane & 3) * 16;
#pragma unroll
    for (int i = 0; i < 8; ++i) *(LAS v4u*)(kw + i * 8 * RKT_STRIDE) = kr[i];
#pragma unroll
    for (int i = 0; i < 4; ++i) *(LAS v4u*)(vw + i * 16 * RVT_STRIDE) = vr[i];
    asm volatile("s_waitcnt lgkmcnt(0)" ::: "memory");
}
__device__ __forceinline__ void ret_state_update(f32x4 (&st)[4][2], const bf16x8 (&vf)[2][2], const LAS unsigned char* kt, int fr, int fq) {
#pragma unroll
    for (int dt = 0; dt < 4; ++dt)
#pragma unroll
        for (int ks = 0; ks < 2; ++ks) {
            const LAS unsigned char* p = kt + (32 * ks + 4 * fq + (fr >> 2)) * RKT_STRIDE + (16 * dt + 4 * (fr & 3)) * 2;
            const bf16x8 kf = tr8(p, p + 16 * RKT_STRIDE);
#pragma unroll
            for (int et = 0; et < 2; ++et) st[dt][et] = MFMA16(kf, vf[et][ks], st[dt][et]);
        }
}
__device__ __forceinline__ void ret_load_vf(bf16x8 (&vf)[2][2], const LAS unsigned char* vt, int fr, int fq) {
#pragma unroll
    for (int et = 0; et < 2; ++et)
#pragma unroll
        for (int ks = 0; ks < 2; ++ks) { const LAS unsigned char* p = vt + (32 * ks + 4 * fq + (fr >> 2)) * RVT_STRIDE + (16 * et + 4 * (fr & 3)) * 2; vf[et][ks] = tr8(p, p + 16 * RVT_STRIDE); }
}
__device__ __forceinline__ void ret_runstate(Frame& F) {
    const int fr = F.lane & 15, fq = F.lane >> 4;
    LAS unsigned char* kt = F.lds + F.wave * RWAVE_LDS; LAS unsigned char* vt = kt + 64 * RKT_STRIDE;
    float* ET = (float*)(F.ws + WS_KV);
    for (int it = F.bid * NWAVES + F.wave; it < RH * NRUN * 4; it += F.G * NWAVES) {
        const int eq = it & 3, h = (it >> 2) & 7, r = it >> 5;
        const float dec = exp2f(64.0f * ret_lg2(h));
        f32x4 st[4][2];
#pragma unroll
        for (int dt = 0; dt < 4; ++dt)
#pragma unroll
            for (int et = 0; et < 2; ++et) st[dt][et] = (f32x4){0.f, 0.f, 0.f, 0.f};
        for (int cc = 0; cc < RUN; ++cc) {
            ret_stage(F, kt, vt, r * RUN + cc, h, eq);
            bf16x8 vf[2][2]; ret_load_vf(vf, vt, fr, fq);
#pragma unroll
            for (int dt = 0; dt < 4; ++dt)
#pragma unroll
                for (int et = 0; et < 2; ++et) st[dt][et] = st[dt][et] * dec;
            ret_state_update(st, vf, kt, fr, fq);
        }
        float* o = ET + ((size_t)(h * NRUN + r) * 128 + eq * 32) * 64;
#pragma unroll
        for (int dt = 0; dt < 4; ++dt)
#pragma unroll
            for (int et = 0; et < 2; ++et) *(f32x4*)(o + (size_t)(16 * et + fr) * 64 + 16 * dt + 4 * fq) = st[dt][et];
    }
}
__device__ __forceinline__ void ret_runscan(Frame& F) {
    const int gt = F.bid * NTHREADS + F.tid;
    if (gt < RH * 8192) {
        const int h = gt >> 13, ed = gt & 8191; const float dec = exp2f(256.0f * ret_lg2(h));
        float* p = (float*)(F.ws + WS_KV) + (size_t)h * NRUN * 8192 + ed;
        float v[NRUN];
#pragma unroll
        for (int r = 0; r < NRUN; ++r) v[r] = p[(size_t)r * 8192];
        float stt = 0.f;
#pragma unroll
        for (int r = 0; r < NRUN; ++r) { const float e = v[r]; p[(size_t)r * 8192] = stt; stt = stt * dec + e; }
    }
}
__device__ __forceinline__ void ret_out_mfma(Frame& F) {
    const int fr = F.lane & 15, fq = F.lane >> 4;
    LAS unsigned char* kt = F.lds + F.wave * RWAVE_LDS; LAS unsigned char* vt = kt + 64 * RKT_STRIDE;
    LAS float* xch = (LAS float*)(F.lds + NWAVES * RWAVE_LDS);
    const float* ET = (const float*)(F.ws + WS_KV);
    const bf16* Qb = (const bf16*)(F.ws + WS_Q); const bf16* ZR = (const bf16*)(F.ws + WS_ZR); bf16* YR = (bf16*)(F.ws + WS_YR);
    for (int bi = F.bid; bi < RH * NRUN / 2; bi += F.G) {
        const int pair = F.wave >> 2, eq = F.wave & 3, hr = bi * 2 + pair, h = hr & 7, r = hr >> 3;
        const float lg2_ = ret_lg2(h), dec = exp2f(64.0f * lg2_);
        f32x4 st[4][2];
        { const float* c = ET + ((size_t)(h * NRUN + r) * 128 + eq * 32) * 64;
#pragma unroll
            for (int dt = 0; dt < 4; ++dt)
#pragma unroll
                for (int et = 0; et < 2; ++et) st[dt][et] = *(const f32x4*)(c + (size_t)(16 * et + fr) * 64 + 16 * dt + 4 * fq); }
        for (int cc = 0; cc < RUN; ++cc) {
            const int n = r * RUN + cc;
            const int ql = fr * RQK + 4 * fq, zl = fr * RW + 4 * fq;
            float lg2 = lg2_; asm volatile("" : "+v"(lg2));
            ret_stage(F, kt, vt, n, h, eq);
#define LOAD_QF(qf, it) do { _Pragma("unroll") for (int ks = 0; ks < 2; ++ks) { const bf16* qp = (Qb + (size_t)(n * 64 + 16 * (it)) * RQK + h * 64 + 32 * ks) + ql; \
                    const v2u a_ = *(const v2u*)qp, b_ = *(const v2u*)(qp + 16); v4u w_; w_.x = a_.x; w_.y = a_.y; w_.z = b_.x; w_.w = b_.y; qf[ks] = __builtin_bit_cast(bf16x8, w_); } } while (0)
            f32x4 o[2][4];
            {
                const bf16x8 p00 = pack8(st[0][0], st[1][0]), p01 = pack8(st[2][0], st[3][0]), p10 = pack8(st[0][1], st[1][1]), p11 = pack8(st[2][1], st[3][1]);
#pragma unroll
                for (int it = 0; it < 4; ++it) { bf16x8 qf[2]; LOAD_QF(qf, it);
                    const float xi = __builtin_amdgcn_exp2f((float)(16 * it + fr + 64) * lg2);
                    f32x4 a = (f32x4){0.f, 0.f, 0.f, 0.f}; a = MFMA16(p00, qf[0], a); a = MFMA16(p01, qf[1], a); o[0][it] = a * xi;
                    f32x4 b = (f32x4){0.f, 0.f, 0.f, 0.f}; b = MFMA16(p10, qf[0], b); b = MFMA16(p11, qf[1], b); o[1][it] = b * xi; }
            }
            asm volatile("" ::: "memory");
            bf16x8 vf[2][2]; ret_load_vf(vf, vt, fr, fq);
#pragma unroll
            for (int it = 0; it < 4; ++it) {
                bf16x8 qf[2]; LOAD_QF(qf, it);
                f32x4 sa[4];
#pragma unroll
                for (int jt = 0; jt < 4; ++jt) {
                    f32x4 a = (f32x4){0.f, 0.f, 0.f, 0.f};
#pragma unroll
                    for (int ks = 0; ks < 2; ++ks) { const LAS unsigned char* kp = kt + (16 * jt + fr) * RKT_STRIDE + (32 * ks + 4 * fq) * 2;
                        const v2u ka = *(const LAS v2u*)kp, kb = *(const LAS v2u*)(kp + 32); v4u w; w.x = ka.x; w.y = ka.y; w.z = kb.x; w.w = kb.y;
                        a = MFMA16(__builtin_bit_cast(bf16x8, w), qf[ks], a); }
                    const int i = 16 * it + fr;
#pragma unroll
                    for (int t = 0; t < 4; ++t) { const int j = 16 * jt + 4 * fq + t; const int ex = (i >= j) ? i : (2 * j - i); a[t] *= __builtin_amdgcn_exp2f((float)ex * lg2); }
                    sa[jt] = a;
                }
                const bf16x8 s0 = pack8(sa[0], sa[1]), s1 = pack8(sa[2], sa[3]);
#pragma unroll
                for (int et = 0; et < 2; ++et) { o[et][it] = MFMA16(vf[et][0], s0, o[et][it]); o[et][it] = MFMA16(vf[et][1], s1, o[et][it]); }
                asm volatile("" ::: "memory");
            }
#pragma unroll
            for (int dt = 0; dt < 4; ++dt)
#pragma unroll
                for (int et = 0; et < 2; ++et) st[dt][et] = st[dt][et] * dec;
            ret_state_update(st, vf, kt, fr, fq);
            asm volatile("" ::: "memory");
            LAS float* xb = xch + (cc & 1) * 512 + pair * 256;
            float ss[4];
#pragma unroll
            for (int it = 0; it < 4; ++it) { float q = 0.f;
#pragma unroll
                for (int et = 0; et < 2; ++et) q += (o[et][it][0] * o[et][it][0] + o[et][it][1] * o[et][it][1]) + (o[et][it][2] * o[et][it][2] + o[et][it][3] * o[et][it][3]);
                q += __shfl_xor(q, 16); q += __shfl_xor(q, 32); ss[it] = q; }
            if (fq == 0) {
#pragma unroll
                for (int it = 0; it < 4; ++it) xb[eq * 64 + 16 * it + fr] = ss[it]; }
            __syncthreads();
#pragma unroll
            for (int it = 0; it < 4; ++it) {
                const int i = 16 * it + fr;
                const float tot = (xb[i] + xb[64 + i]) + (xb[128 + i] + xb[192 + i]);
                const float rn = 1.0f / sqrtf(tot * (1.0f / 128.0f) + EPS);
#pragma unroll
                for (int et = 0; et < 2; ++et) {
                    const size_t gu = (size_t)(n * 64 + 16 * it) * RW + h * 128 + eq * 32 + 16 * et;
                    const v2u zw = *(const v2u*)((ZR + gu) + zl);
                    v2u w; w.x = pk2(o[et][it][0] * rn * bflo(zw.x), o[et][it][1] * rn * bfhi(zw.x)); w.y = pk2(o[et][it][2] * rn * bflo(zw.y), o[et][it][3] * rn * bfhi(zw.y));
                    *(v2u*)((YR + gu) + zl) = w;
                }
                asm volatile("" ::: "memory");
            }
        }
    }
}


__device__ __forceinline__ void s5_local_mfma(Frame& F) {
    const int fr = F.lane & 15, fq = F.lane >> 4;
    const bf16* U = (const bf16*)(F.ws + WS_U); const bf16* TW = (const bf16*)(F.ws + WS_TW); float* SL = (float*)(F.ws + WS_S5S);
    for (int it = F.bid * NWAVES + F.wave; it < S5G * 16 * 2; it += F.G * NWAVES) {
        const int cth = it & 1, rt = (it >> 1) & 15, g = it >> 5, c = 16 * rt + fr;
        const bf16* urow = U + ((size_t)g * M + 64 * c + (fq >> 1)) * 16 + 8 * (fq & 1);
        const bf16* wrow = TW + ((size_t)g * 128 + 64 * cth + fr) * 1024 + 8 * fq;
        f32x4 acc[4];
#pragma unroll
        for (int ct = 0; ct < 4; ++ct) acc[ct] = (f32x4){0.f, 0.f, 0.f, 0.f};
#pragma unroll 4
        for (int ks = 0; ks < 32; ++ks) {
            const bf16x8 uf = *(const bf16x8*)(urow + ks * 32);
#pragma unroll
            for (int ct = 0; ct < 4; ++ct) { const bf16x8 wf = *(const bf16x8*)(wrow + (size_t)ct * 16 * 1024 + ks * 32); acc[ct] = MFMA16(wf, uf, acc[ct]); }
        }
#pragma unroll
        for (int ct = 0; ct < 4; ++ct) *(f32x4*)(SL + ((size_t)c * 64 + g) * 128 + 64 * cth + 16 * ct + 4 * fq) = acc[ct];
    }
}
__device__ __forceinline__ void s5_scan2(Frame& F) {
    if (F.bid < 128 || F.bid >= 192) return;
    const int g = F.bid - 128, p = F.lane, c0 = 32 * F.wave;
    const float* SL = (const float*)(F.ws + WS_S5S); bf16* XP = (bf16*)(F.ws + WS_XP);
    const f32x2 a = ((const f32x2*)(F.ws + WS_S5AB))[4096 + g * 64 + p];
    LAS float* ends = (LAS float*)F.lds;
    float sr[32], si[32];
#pragma unroll
    for (int k = 0; k < 32; ++k) { const float* q = SL + ((size_t)(c0 + k) * 64 + g) * 128 + p; sr[k] = q[0]; si[k] = q[64]; }
    float xr = 0.f, xi = 0.f;
#pragma unroll
    for (int k = 0; k < 32; ++k) { const float tr = sr[k], ti = si[k]; sr[k] = xr; si[k] = xi; const float nr = a.x * xr - a.y * xi + tr, ni = a.x * xi + a.y * xr + ti; xr = nr; xi = ni; }
    ends[(F.wave * 64 + p) * 2] = xr; ends[(F.wave * 64 + p) * 2 + 1] = xi;
    __syncthreads();
    float br = a.x, bi = a.y;
#pragma unroll
    for (int q = 0; q < 5; ++q) { const float nr = br * br - bi * bi, ni = 2.0f * br * bi; br = nr; bi = ni; }
    float cr = 0.f, ci = 0.f;
    for (int w = 0; w < F.wave; ++w) { const float er = ends[(w * 64 + p) * 2], ei = ends[(w * 64 + p) * 2 + 1]; const float nr = br * cr - bi * ci + er, ni = br * ci + bi * cr + ei; cr = nr; ci = ni; }
    float pr = 1.f, pi = 0.f;
#pragma unroll
    for (int k = 0; k < 32; ++k) {
        const float orr = sr[k] + pr * cr - pi * ci, oi = si[k] + pr * ci + pi * cr;
        bf16* o = XP + ((size_t)(c0 + k) * 64 + g) * 128 + p; o[0] = (bf16)f2bf(orr); o[64] = (bf16)f2bf(oi);
        const float nr = pr * a.x - pi * a.y, ni = pr * a.y + pi * a.x; pr = nr; pi = ni;
    }
}

__device__ __forceinline__ void final_simple(Frame& F) {
    const int gw = F.bid * NWAVES + F.wave, NGW = F.G * NWAVES;
    const float* T = (const float*)(F.ws + WS_T); const float* x = F.in[0]; const float* gain = F.in[16];
    f32x4 gv[8];
#pragma unroll
    for (int j = 0; j < 8; ++j) gv[j] = *((const f32x4*)gain + F.lane + 64 * j);
    for (int m = gw; m < M; m += NGW) {
        const f32x4* tr = (const f32x4*)(T + (size_t)m * D) + F.lane; const f32x4* xr = (const f32x4*)(x + (size_t)m * D) + F.lane;
        f32x4 v[8]; float s = 0.f;
#pragma unroll
        for (int j = 0; j < 8; ++j) { v[j] = tr[64 * j]; s += (v[j].x * v[j].x + v[j].y * v[j].y) + (v[j].z * v[j].z + v[j].w * v[j].w); }
        const float r = 1.0f / sqrtf(wave_sum(s) * (1.0f / D) + EPS);
        f32x4* o = (f32x4*)(F.out + (size_t)m * D) + F.lane;
#pragma unroll
        for (int j = 0; j < 8; ++j) o[64 * j] = xr[64 * j] + v[j] * r * gv[j];
    }
}

struct Args { const float* in[17]; float* out; unsigned char* ws; int ph_lo, ph_hi; };
constexpr int NPHASES = 10;

__global__ void __launch_bounds__(NTHREADS, 2) fwd_kernel(Args args) {
    extern __shared__ __attribute__((aligned(16))) unsigned char lds_raw[];
    Frame F;
    F.lds = (LAS unsigned char*)lds_raw;
    F.tid = threadIdx.x; F.lane = F.tid & 63; F.wave = __builtin_amdgcn_readfirstlane(F.tid >> 6);
    F.G = gridDim.x; F.bid = blockIdx.x;
#pragma unroll
    for (int i = 0; i < 17; ++i) F.in[i] = args.in[i];
    F.out = args.out; F.ws = args.ws;
    const int lo = args.ph_lo, hi = args.ph_hi;
    volatile LAS unsigned* MISC = (volatile LAS unsigned*)(F.lds + 131072);
    if (F.tid < 64) MISC[F.tid] = 0u;
    __syncthreads();
    XcdBarrier bar = xcd_barrier_post((unsigned*)(F.ws + WS_CTL) + 4096, MISC + 8);
#ifndef PHMASK
#define PHMASK 0x3ff
#endif
#define IN(k) (((PHMASK >> (k)) & 1) && lo <= (k) && (k) < hi)
#define SEAM(k) do { if (IN(k) && IN((k) + 1)) xcd_barrier(bar); } while (0)
    using pg8::bf16_t;
    if (IN(0)) { p0_prologue(F); __syncthreads(); p0_s5_tables(F); } SEAM(0);
    if (IN(1)) {
        pg8::Gemm g{(const bf16_t*)(F.ws + WS_H), (const bf16_t*)(F.ws + WS_WIN), M, NIN, D}; pg8::StaticOrder S; S.init(M, NIN, F.G, F.bid);
        EpiIn E{F.ws};
        pg8::gemm_phase<EpiIn, pg8::StaticOrder, true, true>(F.lds, g, S, E);
    } SEAM(1);
    if (IN(2)) { ret_runstate(F); s5_local_mfma(F); } SEAM(2);
    if (IN(3)) { ret_runscan(F); s5_scan2(F); } SEAM(3);
    if (IN(4)) { ret_out_mfma(F); s5_out_mfma(F); } SEAM(4);
    if (IN(5)) {
        pg8::Gemm g{(const bf16_t*)(F.ws + WS_G), (const bf16_t*)(F.ws + WS_WGLU), M, S5W, S5W}; pg8::StaticOrder S; S.init(M, S5W, F.G, F.bid);
        EpiGlu E{(const bf16*)(F.ws + WS_G), (const bf16*)(F.ws + WS_ZS), F.in[12], (bf16*)(F.ws + WS_YS)};
        pg8::gemm_phase<EpiGlu, pg8::StaticOrder, true, true>(F.lds, g, S, E);
    } SEAM(5);
    if (IN(6)) {
        pg8::Gemm g{(const bf16_t*)(F.ws + WS_YS), (const bf16_t*)(F.ws + WS_WS), M, D, S5W}; pg8::StaticOrder S; S.init(M, D, F.G, F.bid);
        EpiGate<false> E{(const bf16*)(F.ws + WS_GS), nullptr, (bf16*)(F.ws + WS_M1)};
        pg8::gemm_phase<EpiGate<false>, pg8::StaticOrder, true, true>(F.lds, g, S, E);
    } SEAM(6);
    if (IN(7)) {
        pg8::Gemm g{(const bf16_t*)(F.ws + WS_YR), (const bf16_t*)(F.ws + WS_WR), M, D, RW}; pg8::StaticOrder S; S.init(M, D, F.G, F.bid);
        EpiGate<true> E{(const bf16*)(F.ws + WS_GR), (const bf16*)(F.ws + WS_M1), (bf16*)(F.ws + WS_MM)};
        pg8::gemm_phase<EpiGate<true>, pg8::StaticOrder, true, true>(F.lds, g, S, E);
    } SEAM(7);
    if (IN(8)) {
        pg8::Gemm g{(const bf16_t*)(F.ws + WS_MM), (const bf16_t*)(F.ws + WS_WOUT), M, D, D}; pg8::StaticOrder S; S.init(M, D, F.G, F.bid);
        EpiF32P E{(float*)(F.ws + WS_T)};
        pg8::gemm_phase<EpiF32P, pg8::StaticOrder, true, true>(F.lds, g, S, E);
    } SEAM(8);
    if (IN(9)) { final_simple(F); }
#undef IN
#undef SEAM
}

#ifndef MK_PER_PHASE
#define MK_PER_PHASE 0
#endif
extern "C" void kernel_launch(void* const* d_in, const int* in_sizes, int n_in, void* d_out, int out_size, void* d_ws, size_t ws_size, hipStream_t stream) {
    static int grid = 0;
    if (grid == 0) {
        if (n_in != 17 || in_sizes[0] != M * D || out_size != M * D || ws_size < WS_END) { fprintf(stderr, "kernel_launch: unexpected shapes (n_in %d, in0 %d, out %d, ws %zu)\n", n_in, n_in > 0 ? in_sizes[0] : -1, out_size, ws_size); grid = -1; return; }
        int dev = 0, cus = 0, per_cu = 0;
        if (hipGetDevice(&dev) != hipSuccess || hipDeviceGetAttribute(&cus, hipDeviceAttributeMultiprocessorCount, dev) != hipSuccess) { grid = -1; return; }
        if (hipFuncSetAttribute((const void*)fwd_kernel, hipFuncAttributeMaxDynamicSharedMemorySize, LDS_BYTES) != hipSuccess) { fprintf(stderr, "kernel_launch: hipFuncSetAttribute failed\n"); grid = -1; return; }
        if (hipOccupancyMaxActiveBlocksPerMultiprocessor(&per_cu, (const void*)fwd_kernel, NTHREADS, LDS_BYTES) != hipSuccess || per_cu < 1) { fprintf(stderr, "kernel_launch: occupancy query says %d\n", per_cu); per_cu = 1; }
        (void)hipGetLastError();
        grid = cus;
    }
    if (grid < 0) return;
    if (hipMemsetAsync((char*)d_ws + WS_CTL, 0, 65536, stream) != hipSuccess) { fprintf(stderr, "kernel_launch: memset failed\n"); return; }
    Args a{};
    for (int i = 0; i < 17; ++i) a.in[i] = (const float*)d_in[i];
    a.out = (float*)d_out; a.ws = (unsigned char*)d_ws;
#if MK_PER_PHASE
    for (int p = 0; p < NPHASES; ++p) { a.ph_lo = p; a.ph_hi = p + 1; hipLaunchKernelGGL(fwd_kernel, dim3(grid), dim3(NTHREADS), LDS_BYTES, stream, a); }
#else
    a.ph_lo = 0; a.ph_hi = NPHASES;
    void* kargs[] = {&a};
    hipError_t e = hipLaunchCooperativeKernel((const void*)fwd_kernel, dim3(grid), dim3(NTHREADS), kargs, LDS_BYTES, stream);
    if (e != hipSuccess) fprintf(stderr, "kernel_launch: cooperative launch failed: %s (grid %d)\n", hipGetErrorString(e), grid);
#endif
}
```
